# Optimizing an MI355X kernel written in HIP

```python
import math
import jax
import jax.numpy as jnp
from jax import lax
import numpy as np

D_MODEL = 2048
BATCH = 4
SEQ = 2048
DEPTH = 1
DEC_BATCH = 16
DEC_SEQ = 16
PAST_LEN = 1024

CHUNK = 64
QBLK = 128
N_DIFF_HEADS = 8
DIFF_HEAD_DIM = 128
DIFF_VDIM = 2 * DIFF_HEAD_DIM
DIFF_WIDTH = N_DIFF_HEADS * 2 * DIFF_HEAD_DIM
N_GDN_HEADS = 16
GDN_DK = 128
GDN_DV = 128
GDN_QKWIDTH = N_GDN_HEADS * GDN_DK
GDN_VWIDTH = N_GDN_HEADS * GDN_DV
CONV_W = 4
CONV_CH = 2 * GDN_QKWIDTH + GDN_VWIDTH
N_MEM = 256
N_XHEADS = 4
XHEAD_DIM = 128
XWIDTH = N_XHEADS * XHEAD_DIM
D_FF = ((8 * D_MODEL // 3 + 255) // 256) * 256
ALPHA = (2.0 * DEPTH) ** 0.25
BETA = (8.0 * DEPTH) ** -0.25
LN_EPS = 1e-5
NORM_EPS = 1e-6
IN_SIZES = (DIFF_WIDTH, DIFF_WIDTH, N_DIFF_HEADS * DIFF_VDIM,
            GDN_QKWIDTH, GDN_QKWIDTH, GDN_VWIDTH, GDN_VWIDTH,
            N_GDN_HEADS, N_GDN_HEADS, D_MODEL, D_MODEL)
D_IN = sum(IN_SIZES)

kernel_name = "hybrid_streaming_encoder_step"


def layer_norm(x, g, b):
    xf = x.astype(jnp.float32)
    mu = jnp.mean(xf, -1, keepdims=True)
    var = jnp.mean(jnp.square(xf - mu), -1, keepdims=True)
    return ((xf - mu) * lax.rsqrt(var + LN_EPS) * g + b).astype(x.dtype)


def rms_norm(x, g):
    xf = x.astype(jnp.float32)
    return (xf * lax.rsqrt(jnp.mean(xf * xf, -1, keepdims=True) + NORM_EPS) * g).astype(x.dtype)


def l2norm(x):
    xf = x.astype(jnp.float32)
    return (xf * lax.rsqrt(jnp.sum(xf * xf, -1, keepdims=True) + NORM_EPS)).astype(x.dtype)


def alibi_slopes(n):
    return jnp.exp2(-8.0 * jnp.arange(1, n + 1, dtype=jnp.float32) / n)


def split_in(proj):
    return jnp.split(proj, np.cumsum(IN_SIZES)[:-1].tolist(), axis=-1)


def causal_conv(x, buf, w):
    T = x.shape[1]
    xp = jnp.concatenate([buf, x], axis=1)
    y = sum(w[j] * xp[:, j:j + T] for j in range(CONV_W))
    return y, xp[:, -(CONV_W - 1):]


def diff_attention_block(q, k, v, q_pos, k_pos, lam):
    s = jnp.einsum("bqhmd,bkhmd->bhmqk", q, k).astype(jnp.float32) * (DIFF_HEAD_DIM ** -0.5)
    dist = jnp.abs(q_pos[:, None] - k_pos[None, :]).astype(jnp.float32)
    bias = -alibi_slopes(N_DIFF_HEADS)[:, None, None, None] * dist
    allowed = (k_pos[None, :] // CHUNK) <= (q_pos[:, None] // CHUNK)
    p = jax.nn.softmax(jnp.where(allowed, s + bias, -jnp.inf), axis=-1)
    wts = p[:, :, 0] - lam * p[:, :, 1]
    return jnp.einsum("bhqk,bkhe->bqhe", wts.astype(v.dtype), v)


def diff_attention_prompt(q, k, v, lam):
    B, S = q.shape[0], q.shape[1]
    nb = S // QBLK
    k_pos = jnp.arange(S)
    qb = jnp.moveaxis(q.reshape(B, nb, QBLK, N_DIFF_HEADS, 2, DIFF_HEAD_DIM), 1, 0)

    def one_block(args):
        i, qi = args
        return diff_attention_block(qi, k, v, i * QBLK + jnp.arange(QBLK), k_pos, lam)

    o = lax.map(one_block, (jnp.arange(nb), qb))
    return jnp.moveaxis(o, 0, 1).reshape(B, S, N_DIFF_HEADS, DIFF_VDIM)


def gated_delta_chunked(q, k, v, g, beta, s0, c):
    f32 = jnp.float32
    B, T, H, DK = q.shape
    DV = v.shape[-1]
    n = T // c

    def chunks(a):
        return jnp.swapaxes(a.astype(f32).reshape(B, n, c, *a.shape[2:]), 2, 3)

    qc = chunks(q) * (DK ** -0.5)
    kc = chunks(k)
    vc = chunks(v)
    gc = jnp.cumsum(chunks(g), axis=-1)
    bc = chunks(beta)
    tri = jnp.tril(jnp.ones((c, c), dtype=bool))
    strict = jnp.tril(jnp.ones((c, c), dtype=bool), -1)
    decay = jnp.exp(jnp.where(tri, gc[..., :, None] - gc[..., None, :], -jnp.inf))
    kb = kc * bc[..., None]
    m = jnp.where(strict, jnp.einsum("bnhid,bnhjd->bnhij", kb, kc) * decay, 0.0)
    a = m + jnp.eye(c, dtype=f32)
    rhs = jnp.concatenate([vc * bc[..., None], kb * jnp.exp(gc)[..., None]], axis=-1)
    sol = lax.linalg.triangular_solve(a, rhs, left_side=True, lower=True, unit_diagonal=True)
    u, w = sol[..., :DV], sol[..., DV:]
    qk = jnp.where(tri, jnp.einsum("bnhid,bnhjd->bnhij", qc, kc) * decay, 0.0)

    def step(S, xs):
        q_i, k_i, u_i, w_i, qk_i, g_i = xs
        v_new = u_i - jnp.einsum("bhcd,bhde->bhce", w_i, S)
        o = (jnp.einsum("bhcd,bhde->bhce", q_i * jnp.exp(g_i)[..., None], S)
             + jnp.einsum("bhij,bhje->bhie", qk_i, v_new))
        g_last = g_i[..., -1]
        S = (S * jnp.exp(g_last)[..., None, None]
             + jnp.einsum("bhcd,bhce->bhde", k_i * jnp.exp(g_last[..., None] - g_i)[..., None], v_new))
        return S, o

    xs = tuple(jnp.swapaxes(t, 0, 1) for t in (qc, kc, u, w, qk, gc))
    s_fin, o = lax.scan(step, s0.astype(f32), xs)
    o = jnp.swapaxes(jnp.swapaxes(o, 0, 1), 2, 3).reshape(B, T, H, DV)
    return o.astype(v.dtype), s_fin.astype(s0.dtype)


def encoder_layer(x, mem_k, mem_v, past, lam_init,
                  w_in, conv_w, lam_q1, lam_k1, lam_q2, lam_k2, diff_subln_g,
                  gdn_a_log, gdn_dt_bias, gdn_norm_g, w_pa, w_pb, w_o, ln1_g, ln1_b,
                  w_xq, w_xo, ln2_g, ln2_b, w_ff1, w_ff3, w_ff2, ln3_g, ln3_b):
    B, T, _ = x.shape
    proj = jnp.einsum("btd,de->bte", x, w_in)
    dq, dk, dv, gq, gk, gv, gz, ga, gb, gate_a, gate_b = split_in(proj)

    qd = dq.reshape(B, T, N_DIFF_HEADS, 2, DIFF_HEAD_DIM)
    kd = dk.reshape(B, T, N_DIFF_HEADS, 2, DIFF_HEAD_DIM)
    vd = dv.reshape(B, T, N_DIFF_HEADS, DIFF_VDIM)
    f32 = jnp.float32
    lam = (jnp.exp(jnp.sum(lam_q1.astype(f32) * lam_k1.astype(f32)))
           - jnp.exp(jnp.sum(lam_q2.astype(f32) * lam_k2.astype(f32))) + lam_init)
    new_k = kd.reshape(B, T, N_DIFF_HEADS, 2 * DIFF_HEAD_DIM)
    if past is None:
        o_a = diff_attention_prompt(qd, kd, vd, lam)
        buf0 = jnp.zeros((B, CONV_W - 1, CONV_CH), proj.dtype)
        s0 = jnp.zeros((B, N_GDN_HEADS, GDN_DK, GDN_DV), x.dtype)
        c = CHUNK
    else:
        cache_k, cache_v, s0, buf0 = past
        P = cache_k.shape[1]
        k_all = jnp.concatenate([cache_k, new_k], axis=1).reshape(B, P + T, N_DIFF_HEADS, 2, DIFF_HEAD_DIM)
        v_all = jnp.concatenate([cache_v, vd], axis=1)
        o_a = diff_attention_block(qd, k_all, v_all, P + jnp.arange(T), jnp.arange(P + T), lam)
        c = T
    o_a = (rms_norm(o_a, diff_subln_g) * (1.0 - lam_init)).reshape(B, T, DIFF_WIDTH)

    qkv, new_buf = causal_conv(jnp.concatenate([gq, gk, gv], axis=-1), buf0, conv_w)
    qkv = jax.nn.silu(qkv)
    q_g, k_g, v_g = jnp.split(qkv, [GDN_QKWIDTH, 2 * GDN_QKWIDTH], axis=-1)
    q_g = l2norm(q_g.reshape(B, T, N_GDN_HEADS, GDN_DK))
    k_g = l2norm(k_g.reshape(B, T, N_GDN_HEADS, GDN_DK))
    v_g = v_g.reshape(B, T, N_GDN_HEADS, GDN_DV)
    g = -jnp.exp(gdn_a_log.astype(f32)) * jax.nn.softplus(ga.astype(f32) + gdn_dt_bias.astype(f32))
    beta = jax.nn.sigmoid(gb.astype(f32))
    o_b, s_new = gated_delta_chunked(q_g, k_g, v_g, g, beta, s0, c)
    o_b = (rms_norm(o_b, gdn_norm_g) * jax.nn.silu(gz.reshape(B, T, N_GDN_HEADS, GDN_DV))).reshape(B, T, GDN_VWIDTH)

    mix = (jax.nn.sigmoid(gate_a) * jnp.einsum("bte,ed->btd", o_a, w_pa)
           + jax.nn.sigmoid(gate_b) * jnp.einsum("bte,ed->btd", o_b, w_pb))
    h1 = layer_norm(ALPHA * x + jnp.einsum("btd,de->bte", mix, w_o), ln1_g, ln1_b)

    qx = jnp.einsum("btd,de->bte", h1, w_xq).reshape(B, T, N_XHEADS, XHEAD_DIM)
    sx = jnp.einsum("bthd,bmhd->bhtm", qx, mem_k).astype(f32) * (XHEAD_DIM ** -0.5)
    px = jax.nn.softmax(sx, axis=-1)
    ox = jnp.einsum("bhtm,bmhd->bthd", px.astype(mem_v.dtype), mem_v).reshape(B, T, XWIDTH)
    h2 = layer_norm(ALPHA * h1 + jnp.einsum("bte,ed->btd", ox, w_xo), ln2_g, ln2_b)

    f = jax.nn.silu(jnp.einsum("btd,df->btf", h2, w_ff1)) * jnp.einsum("btd,df->btf", h2, w_ff3)
    y = layer_norm(ALPHA * h2 + jnp.einsum("btf,fd->btd", f, w_ff2), ln3_g, ln3_b)
    return y, new_k, vd, s_new, new_buf


def setup_inputs(seed: int = 0) -> dict:
    key = jax.random.key(seed)
    ks = iter(jax.random.split(key, 64))
    L, D = DEPTH, D_MODEL

    def nrm(shape, s):
        return jax.random.normal(next(ks), shape, jnp.float32) * s

    def gain(n):
        return 1.0 + nrm((L, n), 0.02)

    x_prompt = nrm((BATCH, SEQ, D), 1.0)
    x_sample = nrm((DEC_BATCH, DEC_SEQ, D), 1.0)
    mem_prompt = nrm((BATCH, N_MEM, D), 1.0)
    cache_diff_k = nrm((L, DEC_BATCH, PAST_LEN, N_DIFF_HEADS, 2 * DIFF_HEAD_DIM), 1.0)
    cache_diff_v = nrm((L, DEC_BATCH, PAST_LEN, N_DIFF_HEADS, DIFF_VDIM), 0.5)
    state_gdn = nrm((L, DEC_BATCH, N_GDN_HEADS, GDN_DK, GDN_DV), 0.1)
    state_gdn_conv = nrm((L, DEC_BATCH, CONV_W - 1, CONV_CH), 1.0)
    cache_mem_k = nrm((L, DEC_BATCH, N_MEM, N_XHEADS, XHEAD_DIM), 1.0)
    cache_mem_v = nrm((L, DEC_BATCH, N_MEM, N_XHEADS, XHEAD_DIM), 0.5)

    s_in = D ** -0.5
    w_in = jnp.concatenate([
        nrm((L, D, DIFF_WIDTH), s_in),
        nrm((L, D, DIFF_WIDTH), s_in),
        nrm((L, D, N_DIFF_HEADS * DIFF_VDIM), s_in * BETA),
        nrm((L, D, GDN_QKWIDTH), s_in),
        nrm((L, D, GDN_QKWIDTH), s_in),
        nrm((L, D, GDN_VWIDTH), s_in * BETA),
        nrm((L, D, GDN_VWIDTH), s_in),
        nrm((L, D, N_GDN_HEADS), s_in),
        nrm((L, D, N_GDN_HEADS), s_in),
        nrm((L, D, D), s_in),
        nrm((L, D, D), s_in),
    ], axis=-1)
    conv_w = nrm((L, CONV_W, CONV_CH), CONV_W ** -0.5)
    lam_q1 = nrm((L, DIFF_HEAD_DIM), 0.1)
    lam_k1 = nrm((L, DIFF_HEAD_DIM), 0.1)
    lam_q2 = nrm((L, DIFF_HEAD_DIM), 0.1)
    lam_k2 = nrm((L, DIFF_HEAD_DIM), 0.1)
    diff_subln_g = gain(DIFF_VDIM)
    gdn_a_log = jnp.log(jax.random.uniform(next(ks), (L, N_GDN_HEADS), jnp.float32, 1.0, 16.0))
    dt = jnp.exp(jax.random.uniform(next(ks), (L, N_GDN_HEADS), jnp.float32,
                                    math.log(1e-3), math.log(1e-1)))
    gdn_dt_bias = dt + jnp.log(-jnp.expm1(-dt))
    gdn_norm_g = gain(GDN_DV)
    w_pa = nrm((L, DIFF_WIDTH, D), DIFF_WIDTH ** -0.5 * BETA)
    w_pb = nrm((L, GDN_VWIDTH, D), GDN_VWIDTH ** -0.5 * BETA)
    w_o = nrm((L, D, D), D ** -0.5 * BETA)
    ln1_g = gain(D)
    ln1_b = nrm((L, D), 0.02)
    w_xq = nrm((L, D, XWIDTH), s_in)
    w_xk = nrm((L, D, XWIDTH), s_in)
    w_xv = nrm((L, D, XWIDTH), s_in * BETA)
    w_xo = nrm((L, XWIDTH, D), XWIDTH ** -0.5 * BETA)
    ln2_g = gain(D)
    ln2_b = nrm((L, D), 0.02)
    w_ff1 = nrm((L, D, D_FF), s_in * BETA)
    w_ff3 = nrm((L, D, D_FF), s_in * BETA)
    w_ff2 = nrm((L, D_FF, D), D_FF ** -0.5 * BETA)
    ln3_g = gain(D)
    ln3_b = nrm((L, D), 0.02)
    return {
        "x_prompt": x_prompt, "x_sample": x_sample, "mem_prompt": mem_prompt,
        "cache_diff_k": cache_diff_k, "cache_diff_v": cache_diff_v,
        "state_gdn": state_gdn, "state_gdn_conv": state_gdn_conv,
        "cache_mem_k": cache_mem_k, "cache_mem_v": cache_mem_v,
        "w_in": w_in, "conv_w": conv_w,
        "lam_q1": lam_q1, "lam_k1": lam_k1, "lam_q2": lam_q2, "lam_k2": lam_k2,
        "diff_subln_g": diff_subln_g, "gdn_a_log": gdn_a_log, "gdn_dt_bias": gdn_dt_bias,
        "gdn_norm_g": gdn_norm_g, "w_pa": w_pa, "w_pb": w_pb, "w_o": w_o,
        "ln1_g": ln1_g, "ln1_b": ln1_b,
        "w_xq": w_xq, "w_xk": w_xk, "w_xv": w_xv, "w_xo": w_xo,
        "ln2_g": ln2_g, "ln2_b": ln2_b,
        "w_ff1": w_ff1, "w_ff3": w_ff3, "w_ff2": w_ff2,
        "ln3_g": ln3_g, "ln3_b": ln3_b,
    }


def reference(x_prompt, x_sample, mem_prompt, cache_diff_k, cache_diff_v, state_gdn, state_gdn_conv,
              cache_mem_k, cache_mem_v, w_in, conv_w, lam_q1, lam_k1, lam_q2, lam_k2, diff_subln_g,
              gdn_a_log, gdn_dt_bias, gdn_norm_g, w_pa, w_pb, w_o, ln1_g, ln1_b,
              w_xq, w_xk, w_xv, w_xo, ln2_g, ln2_b, w_ff1, w_ff3, w_ff2, ln3_g, ln3_b):
    yp, ys = x_prompt, x_sample
    Bp = x_prompt.shape[0]
    pk_l, pv_l, ps_l, pc_l, mk_l, mv_l = [], [], [], [], [], []
    sk_l, sv_l, ss_l, sc_l = [], [], [], []
    for l in range(DEPTH):
        lam_init = 0.8 - 0.6 * math.exp(-0.3 * l)
        lw = (w_in[l], conv_w[l], lam_q1[l], lam_k1[l], lam_q2[l], lam_k2[l], diff_subln_g[l],
              gdn_a_log[l], gdn_dt_bias[l], gdn_norm_g[l], w_pa[l], w_pb[l], w_o[l], ln1_g[l], ln1_b[l],
              w_xq[l], w_xo[l], ln2_g[l], ln2_b[l], w_ff1[l], w_ff3[l], w_ff2[l], ln3_g[l], ln3_b[l])
        mem_k = jnp.einsum("bmd,de->bme", mem_prompt, w_xk[l]).reshape(Bp, N_MEM, N_XHEADS, XHEAD_DIM)
        mem_v = jnp.einsum("bmd,de->bme", mem_prompt, w_xv[l]).reshape(Bp, N_MEM, N_XHEADS, XHEAD_DIM)
        yp, pk, pv, ps, pc = encoder_layer(yp, mem_k, mem_v, None, lam_init, *lw)
        past = (cache_diff_k[l], cache_diff_v[l], state_gdn[l], state_gdn_conv[l])
        ys, sk, sv, ss, sc = encoder_layer(ys, cache_mem_k[l], cache_mem_v[l], past, lam_init, *lw)
        pk_l.append(pk); pv_l.append(pv); ps_l.append(ps); pc_l.append(pc)
        mk_l.append(mem_k); mv_l.append(mem_v)
        sk_l.append(sk); sv_l.append(sv); ss_l.append(ss); sc_l.append(sc)
    return (yp, ys,
            jnp.stack(pk_l), jnp.stack(pv_l), jnp.stack(ps_l), jnp.stack(pc_l),
            jnp.stack(mk_l), jnp.stack(mv_l),
            jnp.stack(sk_l), jnp.stack(sv_l), jnp.stack(ss_l), jnp.stack(sc_l))
```

```cpp
#include <hip/hip_runtime.h>
#include <hip/hip_cooperative_groups.h>
#include <cstdio>
namespace cg = cooperative_groups;

#define LAS __attribute__((address_space(3)))
#define DEV __device__ __forceinline__
typedef unsigned short bf16_t;
typedef short bf16x8 __attribute__((ext_vector_type(8)));
typedef float f32x4 __attribute__((ext_vector_type(4)));
typedef unsigned u32x4 __attribute__((ext_vector_type(4)));
typedef unsigned u32x2 __attribute__((ext_vector_type(2)));

constexpr int DM = 2048, SEQ = 2048, NB = 4, MP = NB * SEQ, SB = 16, ST = 16, MS = SB * ST, MT = MP + MS;
constexpr int PAST = 1024, NMEM = 256, DFF = 5632, XW = 512;
constexpr int NPROJ = 18688;
constexpr float ALPHA = 1.189207115002721f;
constexpr float LAM_INIT = 0.2f;
constexpr float LOG2E = 1.4426950408889634f;

constexpr size_t O_YP = 0, O_DKP = 17301504, O_DVP = 34078720, O_GSP = 50855936, O_GCP = 51904512, O_MKP = 51978240,
                 O_MVP = 52502528, O_DKS = 53026816, O_DVS = 53551104, O_GSS = 54075392, O_GCS = 58269696;

constexpr size_t SZ_ACT = (size_t)MT * DM * 2;
constexpr size_t W_WIN = 0;
constexpr size_t W_OA = W_WIN, W_OB = W_WIN + SZ_ACT;
constexpr size_t W_WXKV = W_WIN + (size_t)NPROJ * DM * 2;
constexpr size_t W_WPA = W_WXKV + (size_t)1024 * DM * 2;
constexpr size_t W_WPB = W_WPA + (size_t)DM * DM * 2;
constexpr size_t W_WO = W_WPB + (size_t)DM * DM * 2;
constexpr size_t W_WXQ = W_WO + (size_t)DM * DM * 2;
constexpr size_t W_WXO = W_WXQ + (size_t)XW * DM * 2;
constexpr size_t W_WFF13 = W_WXO + (size_t)DM * XW * 2;
constexpr size_t W_WFF2 = W_WFF13 + (size_t)2 * DFF * DM * 2;
constexpr size_t W_XB = W_WFF2 + (size_t)DM * DFF * 2;
constexpr size_t W_PRE = W_XB;
constexpr size_t W_MEMB = W_XB + SZ_ACT;
constexpr size_t W_VT = W_MEMB + (size_t)1024 * DM * 2;
constexpr size_t W_QB = W_VT + (size_t)8192 * SEQ * 2;
constexpr size_t W_H1F = W_QB;
constexpr size_t W_KB = W_QB + SZ_ACT;
constexpr size_t W_GB = W_KB + SZ_ACT;
constexpr size_t W_F = W_GB;
constexpr size_t W_ZB = W_GB + (size_t)MT * 6144 * 2;
constexpr size_t W_GATE = W_ZB + SZ_ACT;
constexpr size_t W_H2F = W_GATE;
constexpr size_t W_GAB = W_GATE + (size_t)MT * 4096 * 2;
constexpr size_t W_MEMK = W_GAB + (size_t)MT * 32 * 4;
constexpr size_t W_MEMVT = W_MEMK + (size_t)1024 * 512 * 2;
constexpr size_t W_GDN = W_MEMVT + (size_t)1024 * 512 * 2;
constexpr size_t GP_W = 0, GP_UT = 16384, GP_QG = 32768, GP_QK = 49152, GP_KDT = 57344, GP_SZ = 73728;
constexpr size_t GS_W = 0, GS_UT = 4096, GS_QG = 8192, GS_QK = 12288, GS_KDT = 13312, GS_SZ = 21504;
constexpr size_t W_GDNS = W_GDN + (size_t)2048 * GP_SZ;
constexpr size_t W_DEC = W_GDNS + (size_t)256 * GS_SZ;
constexpr size_t W_MISC = W_DEC + 16384;
constexpr size_t W_XBAR = W_MISC + 256;
constexpr size_t W_PS = W_XBAR + 13824;
constexpr size_t W_END = W_PS + (size_t)12 * MS * DM * 4;
constexpr size_t W_PSM = W_PS + (size_t)8 * MS * DM * 4;
constexpr size_t W_QXP = W_GB;
constexpr size_t W_SCR = W_GB;
constexpr size_t W_MIX = W_GDN, W_H1B = W_MIX + SZ_ACT, W_H2B = W_H1B + SZ_ACT, W_QX = W_H2B + SZ_ACT, W_OX = W_QX + (size_t)MT * XW * 2;
static_assert(W_OX + (size_t)MT * XW * 2 <= W_GDNS, "overlay");
static_assert(W_PRE + (size_t)MT * DM * 4 <= W_QB, "overlay pre");

constexpr int LDS_BYTES = 144 * 1024;

struct P { const float* in[35]; float* out; unsigned char* ws; int ph_lo, ph_hi, dup, pad; };

DEV int get_tid() { int t = threadIdx.x; asm volatile("" : "+v"(t)); return t; }
DEV int get_bid() { int t = blockIdx.x; asm volatile("" : "+s"(t)); return t; }
typedef __bf16 bf16x2_t __attribute__((ext_vector_type(2)));
typedef float f32x2_t __attribute__((ext_vector_type(2)));
DEV unsigned pk_bf16(float lo, float hi) { const f32x2_t v = {lo, hi}; return __builtin_bit_cast(unsigned, __builtin_convertvector(v, bf16x2_t)); }
DEV float bf2f(unsigned h) { return __uint_as_float(h << 16); }
DEV float bflo(unsigned w) { return __uint_as_float(w << 16); }
DEV float bfhi(unsigned w) { return __uint_as_float(w & 0xffff0000u); }
DEV float sigmoidf_(float x) { return 1.0f / (1.0f + __expf(-x)); }
DEV float siluf_(float x) { return x * sigmoidf_(x); }
DEV float ex2(float x) { return __builtin_amdgcn_exp2f(x); }
DEV u32x2 pk4(f32x4 v) { u32x2 r; r.x = pk_bf16(v[0], v[1]); r.y = pk_bf16(v[2], v[3]); return r; }

namespace pg8 {
constexpr int BM = 256, BK = 64, HALF = 128, HTB = HALF * BK * 2, STAGE_BYTES = 8 * HTB, NXCD = 8, WGM = 8;
DEV int lds_byte(int r, int c) { const int st = (r >> 4) * 2 + (c >> 5), rr = r & 15, cc = c & 31, ob = rr * 64 + cc * 2; return st * 1024 + (ob ^ (((ob >> 9) & 1) << 5)); }
DEV void stage_rc(int b, int& R, int& C) { const int st = b / 1024, sb = b % 1024, swz = sb ^ (((sb >> 9) & 1) << 5); R = (st >> 1) * 16 + swz / 64; C = (st & 1) * 32 + (swz % 64) / 2; }
struct Unit { int pm, pn, kbeg, klen; };
struct Gemm { const bf16_t* A; const bf16_t* Bt; int M, N, K; const bf16_t* A2; };
struct StaticOrder {
    int nM, nN, nwg, G, c, K;
    DEV void init(int M, int N, int G_, int c_, int K_) { nM = M / BM; nN = N / BM; nwg = nM * nN; G = G_; c = c_; K = K_; }
    DEV bool next(int i, Unit& u) const {
        const long L = (long)i * G + c; if (L >= nwg) return false;
        u.kbeg = 0; u.klen = K;
        int wgid = (int)L; { const int q = nwg / NXCD, r = nwg % NXCD, xcd = wgid % NXCD, off = wgid / NXCD; wgid = (xcd < r ? xcd * (q + 1) : r * (q + 1) + (xcd - r) * q) + off; }
        const int nig = WGM * nN, gid = wgid / nig, fm = gid * WGM, gsz = (nM - fm) < WGM ? (nM - fm) : WGM;
        u.pm = fm + ((wgid % nig) % gsz); u.pn = (wgid % nig) / gsz; return true;
    }
};
struct SplitOrder {
    int nN, G, c, K, klen, nsplit, coff;
    DEV bool next(int i, Unit& u) const {
        const int nwg = 32 * nN; const long L = (long)i * G + ((i == 0) ? c : (c - coff + G) % G);
        if (L < nwg) { int wgid = (int)L; { const int q = nwg / NXCD, r = nwg % NXCD, xcd = wgid % NXCD, off = wgid / NXCD; wgid = (xcd < r ? xcd * (q + 1) : r * (q + 1) + (xcd - r) * q) + off; }
            const int nig = WGM * nN, gid = wgid / nig, fm = gid * WGM, gsz = (32 - fm) < WGM ? (32 - fm) : WGM;
            u.pm = fm + ((wgid % nig) % gsz); u.pn = (wgid % nig) / gsz; u.kbeg = 0; u.klen = K; return true; }
        const int pc = (int)(L - nwg); if (pc >= nN * nsplit) return false;
        u.pm = 32; u.pn = pc % nN; u.kbeg = (pc / nN) * klen; u.klen = klen; return true;
    }
};
struct PieceOrder {
    int nM, nN, G, c, klen, nsplit;
    DEV bool next(int i, Unit& u) const {
        const long L = (long)i * G + c; if (L >= (long)nM * nN * nsplit) return false;
        const int t = (int)(L / nsplit), ks = (int)(L % nsplit);
        u.pm = t % nM; u.pn = t / nM; u.kbeg = ks * klen; u.klen = klen; return true;
    }
};
template <class Epi, class Sched>
DEV void gemm_phase(LAS unsigned char* lds, const Gemm g, const Sched& S, const Epi& E) {
    const int tid = get_tid(), wid = __builtin_amdgcn_readfirstlane(tid >> 6), lane = tid & 63, wr = wid >> 2, wc = wid & 3, fr = lane & 15, fq = lane >> 4;
    const int K = g.K;
    unsigned voffA[2], voffB[2];
#pragma unroll
    for (int i = 0; i < 2; ++i) { int R, C; stage_rc(tid * 16 + i * 8192, R, C); const int r5 = R & 31, Rb = (R & ~31) + 8 * ((r5 & 15) >> 2) + 4 * (r5 >> 4) + (r5 & 3);
        voffA[i] = (unsigned)(R * K + C) * 2u; voffB[i] = (unsigned)(Rb * K + C) * 2u; }
    const size_t kstep = (size_t)(BK * 2);
    const size_t hstep = (size_t)HALF * K * 2;
    const size_t tstep = 2 * hstep;
    const unsigned ldsw = (unsigned)wid * 1024u;
    const int aoff = lds_byte(wr * 64 + fr, fq * 8), boff = lds_byte(wc * 32 + fr, fq * 8);
#define PG8_SA(b, h) (((b) * 2 + (h)) * HTB)
#define PG8_SB(b, h) ((4 + (b) * 2 + (h)) * HTB)
#define PG8_STAGE(bufoff, gbase, voff) do { _Pragma("unroll") for (int _i = 0; _i < 2; ++_i) \
        __builtin_amdgcn_global_load_lds((const unsigned*)((const char*)(gbase) + (voff)[_i]), (LAS unsigned*)(lds + (bufoff) + ldsw + _i * 8192), 16, 0, 0); } while (0)
#define PG8_LDA(dst, b, h) do { _Pragma("unroll") for (int m = 0; m < 4; ++m) _Pragma("unroll") for (int k = 0; k < 2; ++k) dst[m][k] = *(const LAS bf16x8*)(lds + PG8_SA(b, h) + aoff + m * 2048 + k * 1024); } while (0)
#define PG8_LDB(dst, b, h) do { _Pragma("unroll") for (int n = 0; n < 2; ++n) _Pragma("unroll") for (int k = 0; k < 2; ++k) dst[n][k] = *(const LAS bf16x8*)(lds + PG8_SB(b, h) + boff + n * 2048 + k * 1024); } while (0)
#define PG8_MMA(ai, bj, At, Bt) do { __builtin_amdgcn_s_setprio(1); _Pragma("unroll") for (int m = 0; m < 4; ++m) _Pragma("unroll") for (int n = 0; n < 2; ++n) _Pragma("unroll") for (int k = 0; k < 2; ++k) \
        acc[ai][bj][m][n] = __builtin_amdgcn_mfma_f32_16x16x32_bf16(Bt[n][k], At[m][k], acc[ai][bj][m][n], 0, 0, 0); __builtin_amdgcn_s_setprio(0); } while (0)
#define PG8_WAIT_V(n) asm volatile("s_waitcnt vmcnt(" #n ")" ::: "memory")
#define PG8_WAIT_L(n) asm volatile("s_waitcnt lgkmcnt(" #n ")" ::: "memory")
#define PG8_BAR __builtin_amdgcn_s_barrier()
#define PG8_SCHED __builtin_amdgcn_sched_barrier(0)
    Unit cur, nxt; int ui = 0;
    if (!S.next(0, cur)) return;
    int nt = cur.klen / BK;
    f32x4 acc[2][2][4][2];
#pragma unroll
    for (int a = 0; a < 2; ++a)
#pragma unroll
        for (int b = 0; b < 2; ++b)
#pragma unroll
            for (int m = 0; m < 4; ++m)
#pragma unroll
                for (int n = 0; n < 2; ++n) acc[a][b][m][n] = (f32x4){0.f, 0.f, 0.f, 0.f};
    bf16x8 At[4][2], B0[2][2], B1[2][2];
    const char* cA = ((g.A2 && cur.pm == 32) ? (const char*)g.A2 : (const char*)g.A + (size_t)cur.pm * tstep) + (size_t)cur.kbeg * 2; const char* cB = (const char*)g.Bt + (size_t)cur.pn * tstep + (size_t)cur.kbeg * 2;
    PG8_STAGE(PG8_SB(0, 0), cB, voffB); PG8_STAGE(PG8_SA(0, 0), cA, voffA); PG8_STAGE(PG8_SB(0, 1), cB + hstep, voffB); PG8_STAGE(PG8_SA(0, 1), cA + hstep, voffA);
    if (wr == 1) PG8_BAR;
    PG8_WAIT_V(4); PG8_BAR;
    PG8_STAGE(PG8_SB(1, 0), cB + kstep, voffB); PG8_STAGE(PG8_SA(1, 0), cA + kstep, voffA); PG8_STAGE(PG8_SB(1, 1), cB + hstep + kstep, voffB);
    PG8_WAIT_V(6); PG8_BAR;
    for (;;) {
        const bool has_next = S.next(ui + 1, nxt);
        const char* nA = has_next ? ((g.A2 && nxt.pm == 32) ? (const char*)g.A2 : (const char*)g.A + (size_t)nxt.pm * tstep) + (size_t)nxt.kbeg * 2 : cA; const char* nB = has_next ? (const char*)g.Bt + (size_t)nxt.pn * tstep + (size_t)nxt.kbeg * 2 : cB;
        for (int t = 0; t < nt; t += 2) {
            const bool last = (t == nt - 2);
            const char* a1 = cA + (size_t)(t + 1) * kstep;
            const char* a2 = last ? nA : cA + (size_t)(t + 2) * kstep; const char* b2 = last ? nB : cB + (size_t)(t + 2) * kstep;
            const char* a3 = a2 + kstep; const char* b3 = b2 + kstep;
            PG8_LDB(B0, 0, 0); PG8_SCHED; PG8_LDA(At, 0, 0); PG8_STAGE(PG8_SA(1, 1), a1 + hstep, voffA);
            PG8_WAIT_L(8); PG8_BAR; PG8_WAIT_L(0); PG8_MMA(0, 0, At, B0); PG8_BAR; PG8_SCHED;
            PG8_LDB(B1, 0, 1); PG8_STAGE(PG8_SB(0, 0), b2, voffB);
            PG8_BAR; PG8_WAIT_L(0); PG8_MMA(0, 1, At, B1); PG8_BAR;
            PG8_LDA(At, 0, 1); PG8_STAGE(PG8_SA(0, 0), a2, voffA);
            PG8_BAR; PG8_WAIT_L(0); PG8_MMA(1, 0, At, B0); PG8_BAR; PG8_SCHED;
            PG8_STAGE(PG8_SB(0, 1), b2 + hstep, voffB);
            PG8_WAIT_V(6); PG8_BAR; PG8_MMA(1, 1, At, B1); PG8_BAR;
            PG8_LDB(B0, 1, 0); PG8_SCHED; PG8_LDA(At, 1, 0); PG8_STAGE(PG8_SA(0, 1), a2 + hstep, voffA);
            PG8_WAIT_L(8); PG8_BAR; PG8_WAIT_L(0); PG8_MMA(0, 0, At, B0); PG8_BAR; PG8_SCHED;
            PG8_LDB(B1, 1, 1); PG8_STAGE(PG8_SB(1, 0), b3, voffB);
            PG8_BAR; PG8_WAIT_L(0); PG8_MMA(0, 1, At, B1); PG8_BAR;
            PG8_LDA(At, 1, 1); PG8_STAGE(PG8_SA(1, 0), a3, voffA);
            PG8_BAR; PG8_WAIT_L(0); PG8_MMA(1, 0, At, B0); PG8_BAR; PG8_SCHED;
            PG8_STAGE(PG8_SB(1, 1), b3 + hstep, voffB);
            PG8_WAIT_V(6); PG8_BAR; PG8_MMA(1, 1, At, B1); PG8_BAR;
        }
        E(acc, cur, wr, wc, fr, fq);
        if (!has_next) break;
#pragma unroll
        for (int a = 0; a < 2; ++a)
#pragma unroll
            for (int b = 0; b < 2; ++b)
#pragma unroll
                for (int m = 0; m < 4; ++m)
#pragma unroll
                    for (int n = 0; n < 2; ++n) acc[a][b][m][n] = (f32x4){0.f, 0.f, 0.f, 0.f};
        cur = nxt; cA = nA; cB = nB; ++ui; nt = cur.klen / BK;
    }
    PG8_WAIT_V(0);
    if (wr == 0) PG8_BAR;
    PG8_BAR;
#undef PG8_SA
#undef PG8_SB
#undef PG8_STAGE
#undef PG8_LDA
#undef PG8_LDB
#undef PG8_MMA
#undef PG8_WAIT_V
#undef PG8_WAIT_L
#undef PG8_BAR
#undef PG8_SCHED
}
}
using pg8::Unit;
typedef f32x4 Acc[2][2][4][2];

#define EPI_FOR(ROW0, COL0) \
    _Pragma("unroll") for (int ai = 0; ai < 2; ++ai) _Pragma("unroll") for (int m = 0; m < 4; ++m) { asm volatile("" ::: "memory"); const int row = (ROW0) + ai * 128 + m * 16; \
    _Pragma("unroll") for (int bj = 0; bj < 2; ++bj) _Pragma("unroll") for (int n = 0; n < 2; ++n) { const int col = (COL0) + bj * 128 + n * 4; const f32x4 v = acc[ai][bj][m][n];
#define EPI_END }}

struct EpiProj {
    unsigned char* ws; float* out;
    DEV void operator()(const Acc& acc, const Unit& u, int wr, int wc, int fr, int fq) const {
        const int row0 = u.pm * 256 + wr * 64 + fr, col0 = u.pn * 256 + wc * 32 + 8 * fq;
        const int reg = u.pn >> 3;
        if (u.pn == 72) {
            if (wc == 0) { float* gab = (float*)(ws + W_GAB);
#pragma unroll
                for (int ai = 0; ai < 2; ++ai)
#pragma unroll
                    for (int m = 0; m < 4; ++m)
#pragma unroll
                        for (int n = 0; n < 2; ++n) { const int row = row0 + ai * 128 + m * 16; *(f32x4*)(gab + (size_t)row * 32 + n * 4 + 8 * fq) = acc[ai][0][m][n]; } }
            return;
        }
        if (reg == 0) { bf16_t* Q = (bf16_t*)(ws + W_QB);
            EPI_FOR(row0, col0) *(u32x2*)(Q + (size_t)row * DM + col) = pk4(v); EPI_END
        } else if (reg == 1) { bf16_t* Kb = (bf16_t*)(ws + W_KB);
            EPI_FOR(row0, col0 - 2048) *(u32x2*)(Kb + (size_t)row * DM + col) = pk4(v);
                float* o = row < MP ? out + O_DKP + (size_t)row * DM : out + O_DKS + (size_t)(row - MP) * DM;
                if (u.pm < 32) __builtin_nontemporal_store(v, (f32x4*)(o + col)); else *(f32x4*)(o + col) = v; EPI_END
        } else if (reg == 2) { bf16_t* VT = (bf16_t*)(ws + W_VT);
            EPI_FOR(row0, col0 - 4096)
                float* o = row < MP ? out + O_DVP + (size_t)row * DM : out + O_DVS + (size_t)(row - MP) * DM;
                if (u.pm < 32) __builtin_nontemporal_store(v, (f32x4*)(o + col)); else *(f32x4*)(o + col) = v;
                if (row < MP) { const int b = row >> 11, t = row & 2047; bf16_t* d = VT + ((size_t)(b * 2048 + col)) * SEQ + t;
                    const u32x2 pk = pk4(v); d[0] = (bf16_t)(pk.x & 0xffff); d[SEQ] = (bf16_t)(pk.x >> 16); d[2 * SEQ] = (bf16_t)(pk.y & 0xffff); d[3 * SEQ] = (bf16_t)(pk.y >> 16); }
            EPI_END
        } else if (reg <= 5) { bf16_t* G = (bf16_t*)(ws + W_GB);
            EPI_FOR(row0, col0 - 6144) *(u32x2*)(G + (size_t)row * 6144 + col) = pk4(v);
                if (row < MP) { const int t = row & 2047; if (t >= 2045) *(f32x4*)(out + O_GCP + ((size_t)(row >> 11) * 3 + (t - 2045)) * 6144 + col) = v; }
                else { const int t = (row - MP) & 15; if (t >= 13) *(f32x4*)(out + O_GCS + ((size_t)((row - MP) >> 4) * 3 + (t - 13)) * 6144 + col) = v; }
            EPI_END
        } else if (reg == 6) { bf16_t* Z = (bf16_t*)(ws + W_ZB);
            EPI_FOR(row0, col0 - 12288) *(u32x2*)(Z + (size_t)row * DM + col) = pk4(v); EPI_END
        } else { bf16_t* GT = (bf16_t*)(ws + W_GATE);
            EPI_FOR(row0, col0 - 14336) f32x4 s; s[0] = sigmoidf_(v[0]); s[1] = sigmoidf_(v[1]); s[2] = sigmoidf_(v[2]); s[3] = sigmoidf_(v[3]);
                *(u32x2*)(GT + (size_t)row * 4096 + col) = pk4(s); EPI_END
        }
    }
};
struct EpiMemKV {
    unsigned char* ws; float* out;
    DEV void operator()(const Acc& acc, const Unit& u, int wr, int wc, int fr, int fq) const {
        const int row0 = u.pm * 256 + wr * 64 + fr, col0 = u.pn * 256 + wc * 32 + 8 * fq;
        if (u.pn < 2) { bf16_t* MK = (bf16_t*)(ws + W_MEMK);
            EPI_FOR(row0, col0) *(u32x2*)(MK + (size_t)row * 512 + col) = pk4(v); *(f32x4*)(out + O_MKP + (size_t)row * 512 + col) = v; EPI_END
        } else { bf16_t* MVT = (bf16_t*)(ws + W_MEMVT);
            EPI_FOR(row0, col0 - 512) *(f32x4*)(out + O_MVP + (size_t)row * 512 + col) = v;
                const int b = row >> 8, mm = row & 255; bf16_t* d = MVT + ((size_t)(b * 512 + col)) * 256 + mm; const u32x2 pk = pk4(v);
                d[0] = (bf16_t)(pk.x & 0xffff); d[256] = (bf16_t)(pk.x >> 16); d[512] = (bf16_t)(pk.y & 0xffff); d[768] = (bf16_t)(pk.y >> 16); EPI_END
        }
    }
};
struct EpiMergeA {
    unsigned char* ws;
    DEV void operator()(const Acc& acc, const Unit& u, int wr, int wc, int fr, int fq) const {
        const int row0 = u.pm * 256 + wr * 64 + fr, col0 = u.pn * 256 + wc * 32 + 8 * fq;
        const bf16_t* GT = (const bf16_t*)(ws + W_GATE); float* PRE = (float*)(ws + W_PRE);
        if (u.pm == 32) { float* MF = (float*)(ws + W_PSM) + (size_t)(u.kbeg >> 10) * MS * DM;
            EPI_FOR(row0, col0) const u32x2 gt = *(const u32x2*)(GT + (size_t)row * 4096 + col);
                f32x4 r; r[0] = v[0] * bflo(gt.x); r[1] = v[1] * bfhi(gt.x); r[2] = v[2] * bflo(gt.y); r[3] = v[3] * bfhi(gt.y); *(f32x4*)(MF + (size_t)(row - MP) * DM + col) = r; EPI_END
            return; }
        EPI_FOR(row0, col0) const u32x2 gt = *(const u32x2*)(GT + (size_t)row * 4096 + col);
            f32x4 r; r[0] = v[0] * bflo(gt.x); r[1] = v[1] * bfhi(gt.x); r[2] = v[2] * bflo(gt.y); r[3] = v[3] * bfhi(gt.y);
            *(f32x4*)(PRE + (size_t)row * DM + col) = r; EPI_END
    }
};
struct EpiMergeB {
    unsigned char* ws;
    DEV void operator()(const Acc& acc, const Unit& u, int wr, int wc, int fr, int fq) const {
        const int row0 = u.pm * 256 + wr * 64 + fr, col0 = u.pn * 256 + wc * 32 + 8 * fq;
        const bf16_t* GT = (const bf16_t*)(ws + W_GATE); const float* PRE = (const float*)(ws + W_PRE); bf16_t* MIX = (bf16_t*)(ws + W_MIX);
        if (u.pm == 32) { float* MF = (float*)(ws + W_PSM) + (size_t)(2 + (u.kbeg >> 10)) * MS * DM;
            EPI_FOR(row0, col0) const u32x2 gt = *(const u32x2*)(GT + (size_t)row * 4096 + 2048 + col);
                f32x4 r; r[0] = v[0] * bflo(gt.x); r[1] = v[1] * bfhi(gt.x); r[2] = v[2] * bflo(gt.y); r[3] = v[3] * bfhi(gt.y); *(f32x4*)(MF + (size_t)(row - MP) * DM + col) = r; EPI_END
            return; }
        EPI_FOR(row0, col0) const u32x2 gt = *(const u32x2*)(GT + (size_t)row * 4096 + 2048 + col); const f32x4 pa = *(const f32x4*)(PRE + (size_t)row * DM + col);
            f32x4 r; r[0] = pa[0] + v[0] * bflo(gt.x); r[1] = pa[1] + v[1] * bfhi(gt.x); r[2] = pa[2] + v[2] * bflo(gt.y); r[3] = pa[3] + v[3] * bfhi(gt.y);
            *(u32x2*)(MIX + (size_t)row * DM + col) = pk4(r); EPI_END
    }
};
struct EpiResid {
    float* PRE; const float* r0; const float* r1;
    DEV void operator()(const Acc& acc, const Unit& u, int wr, int wc, int fr, int fq) const {
        const int row0 = u.pm * 256 + wr * 64 + fr, col0 = u.pn * 256 + wc * 32 + 8 * fq;
        EPI_FOR(row0, col0) const float* rp = row < MP ? r0 + (size_t)row * DM : r1 + (size_t)(row - MP) * DM; const f32x4 x = *(const f32x4*)(rp + col);
            *(f32x4*)(PRE + (size_t)row * DM + col) = x * ALPHA + v; EPI_END
    }
};
struct EpiBf {
    bf16_t* O; int ld;
    DEV void operator()(const Acc& acc, const Unit& u, int wr, int wc, int fr, int fq) const {
        const int row0 = u.pm * 256 + wr * 64 + fr, col0 = u.pn * 256 + wc * 32 + 8 * fq;
        EPI_FOR(row0, col0) *(u32x2*)(O + (size_t)row * ld + col) = pk4(v); EPI_END
    }
};
struct EpiPart {
    float* PS; int ld, klen; size_t stride;
    DEV void operator()(const Acc& acc, const Unit& u, int wr, int wc, int fr, int fq) const {
        const int row0 = u.pm * 256 + wr * 64 + fr, col0 = u.pn * 256 + wc * 32 + 8 * fq;
        float* ps = PS + (size_t)(u.kbeg / klen) * stride;
        EPI_FOR(row0, col0) *(f32x4*)(ps + (size_t)row * ld + col) = v; EPI_END
    }
};
struct EpiSwiglu {
    bf16_t* F;
    DEV void operator()(const Acc& acc, const Unit& u, int wr, int wc, int fr, int fq) const {
        const int row0 = u.pm * 256 + wr * 64 + fr, col0 = u.pn * 128 + wc * 32 + 8 * fq;
#pragma unroll
        for (int ai = 0; ai < 2; ++ai)
#pragma unroll
            for (int m = 0; m < 4; ++m)
#pragma unroll
                for (int n = 0; n < 2; ++n) { const int row = row0 + ai * 128 + m * 16, col = col0 + n * 4; const f32x4 a = acc[ai][0][m][n], b = acc[ai][1][m][n];
                    f32x4 r; r[0] = siluf_(a[0]) * b[0]; r[1] = siluf_(a[1]) * b[1]; r[2] = siluf_(a[2]) * b[2]; r[3] = siluf_(a[3]) * b[3];
                    *(u32x2*)(F + (size_t)row * DFF + col) = pk4(r); }
    }
};

struct EpiResidSplit {
    float* PRE; const float* r0; const bf16_t* rb; float* PS; int klen;
    DEV void operator()(const Acc& acc, const Unit& u, int wr, int wc, int fr, int fq) const {
        const int row0 = u.pm * 256 + wr * 64 + fr, col0 = u.pn * 256 + wc * 32 + 8 * fq;
        if (u.pm < 32) {
            if (r0) { EPI_FOR(row0, col0) const f32x4 x = *(const f32x4*)(r0 + (size_t)row * DM + col); *(f32x4*)(PRE + (size_t)row * DM + col) = x * ALPHA + v; EPI_END }
            else { EPI_FOR(row0, col0) const u32x2 xb = *(const u32x2*)(rb + (size_t)row * DM + col); f32x4 x; x[0] = bflo(xb.x); x[1] = bfhi(xb.x); x[2] = bflo(xb.y); x[3] = bfhi(xb.y);
                *(f32x4*)(PRE + (size_t)row * DM + col) = x * ALPHA + v; EPI_END }
        } else { float* ps = PS + (size_t)(u.kbeg / klen) * MS * DM;
            EPI_FOR(row0 - MP, col0) *(f32x4*)(ps + (size_t)row * DM + col) = v; EPI_END
        }
    }
};
template <class Epi>
DEV void run_gemm_split(LAS unsigned char* lds, const bf16_t* A, const bf16_t* Bt, int N, int K, int klen, const Epi& E, const bf16_t* A2 = nullptr, int coff = 0) {
    pg8::Gemm g; g.A = A; g.Bt = Bt; g.M = MT; g.N = N; g.K = K; g.A2 = A2;
    pg8::SplitOrder S; S.nN = N / 256; S.G = (int)gridDim.x; S.c = get_bid(); S.K = K; S.klen = klen; S.nsplit = K / klen; S.coff = coff;
    pg8::gemm_phase(lds, g, S, E);
}
template <class Epi>
DEV void run_gemm(LAS unsigned char* lds, const bf16_t* A, const bf16_t* Bt, int M, int N, int K, const Epi& E, int c) {
    pg8::Gemm g; g.A = A; g.Bt = Bt; g.M = M; g.N = N; g.K = K; g.A2 = nullptr;
    pg8::StaticOrder S; S.init(M, N, (int)gridDim.x, c, K);
    pg8::gemm_phase(lds, g, S, E);
}

DEV void conv_tile(const float* __restrict__ src, int ld, int k0, int n0, int nvalid, bf16_t* __restrict__ dst, int K, int drow0, int mode, LAS float* tile) {
    const int tid = get_tid();
    {
        const int n = (tid & 63) * 4, kk = tid >> 6;
#pragma unroll
        for (int i = 0; i < 8; ++i) { const int k = kk + 8 * i;
            f32x4 v = (f32x4){0.f, 0.f, 0.f, 0.f};
            if (n < nvalid) v = *(const f32x4*)(src + (size_t)(k0 + k) * ld + n0 + n);
            LAS float* t = tile + k * 257 + n; t[0] = v[0]; t[1] = v[1]; t[2] = v[2]; t[3] = v[3]; }
    }
    __syncthreads();
#pragma unroll
    for (int i = 0; i < 4; ++i) { const int idx = tid + 512 * i, seg = idx & 7, n = idx >> 3;
        const LAS float* t = tile + (seg * 8) * 257 + n;
        u32x4 o; o.x = pk_bf16(t[0], t[257]); o.y = pk_bf16(t[2 * 257], t[3 * 257]); o.z = pk_bf16(t[4 * 257], t[5 * 257]); o.w = pk_bf16(t[6 * 257], t[7 * 257]);
        int drow;
        if (mode == 0) drow = drow0 + n; else { const int nn = n0 + n; drow = (nn >> 7) * 256 + (nn & 127) + (mode - 1) * 128; }
        *(u32x4*)(dst + (size_t)drow * K + k0 + seg * 8) = o; }
    __syncthreads();
}
DEV void cvt_rows(const float* __restrict__ src, bf16_t* __restrict__ dst, size_t n, size_t gtid, size_t gsz) {
    for (size_t i = gtid * 8; i < n; i += gsz * 8) { const f32x4 a = *(const f32x4*)(src + i), b = *(const f32x4*)(src + i + 4);
        u32x4 o; o.x = pk_bf16(a[0], a[1]); o.y = pk_bf16(a[2], a[3]); o.z = pk_bf16(b[0], b[1]); o.w = pk_bf16(b[2], b[3]); *(u32x4*)(dst + i) = o; }
}
DEV void conv_job(const P& p, int t, LAS float* tile) {
    unsigned char* ws = p.ws;
    const float* src; int ld, K, nc0, nvalid = 256, drow0, mode = 0, ntn, tt; bf16_t* dst;
    if (t < 1792)      { tt = t;    src = p.in[9];  ld = 18464; K = DM;  ntn = 56; dst = (bf16_t*)(ws + W_WIN);  nc0 = 0;     drow0 = 0; }
    else if (t < 2304) { tt = t - 1792; src = p.in[9];  ld = 18464; K = DM;  ntn = 16; dst = (bf16_t*)(ws + W_WIN);  nc0 = 14368; drow0 = 14336; }
    else if (t < 2336) { tt = t - 2304; src = p.in[9];  ld = 18464; K = DM;  ntn = 1;  dst = (bf16_t*)(ws + W_WIN);  nc0 = 14336; drow0 = 18432; nvalid = 32; }
    else if (t < 2400) { tt = t - 2336; src = p.in[25]; ld = XW;    K = DM;  ntn = 2;  dst = (bf16_t*)(ws + W_WXKV); nc0 = 0;     drow0 = 0; }
    else if (t < 2464) { tt = t - 2400; src = p.in[26]; ld = XW;    K = DM;  ntn = 2;  dst = (bf16_t*)(ws + W_WXKV); nc0 = 0;     drow0 = 512; }
    else if (t < 2720) { tt = t - 2464; src = p.in[19]; ld = DM;    K = DM;  ntn = 8;  dst = (bf16_t*)(ws + W_WPA);  nc0 = 0;     drow0 = 0; }
    else if (t < 2976) { tt = t - 2720; src = p.in[20]; ld = DM;    K = DM;  ntn = 8;  dst = (bf16_t*)(ws + W_WPB);  nc0 = 0;     drow0 = 0; }
    else if (t < 3232) { tt = t - 2976; src = p.in[21]; ld = DM;    K = DM;  ntn = 8;  dst = (bf16_t*)(ws + W_WO);   nc0 = 0;     drow0 = 0; }
    else if (t < 3296) { tt = t - 3232; src = p.in[24]; ld = XW;    K = DM;  ntn = 2;  dst = (bf16_t*)(ws + W_WXQ);  nc0 = 0;     drow0 = 0; }
    else if (t < 3360) { tt = t - 3296; src = p.in[27]; ld = DM;    K = XW;  ntn = 8;  dst = (bf16_t*)(ws + W_WXO);  nc0 = 0;     drow0 = 0; }
    else if (t < 4064) { tt = t - 3360; src = p.in[30]; ld = DFF;   K = DM;  ntn = 22; dst = (bf16_t*)(ws + W_WFF13); nc0 = 0;    drow0 = 0; mode = 1; }
    else if (t < 4768) { tt = t - 4064; src = p.in[31]; ld = DFF;   K = DM;  ntn = 22; dst = (bf16_t*)(ws + W_WFF13); nc0 = 0;    drow0 = 0; mode = 2; }
    else           { tt = t - 4768; src = p.in[32]; ld = DM;    K = DFF; ntn = 8;  dst = (bf16_t*)(ws + W_WFF2); nc0 = 0;     drow0 = 0; }
    const int tn = tt % ntn, tk = tt / ntn;
    conv_tile(src, ld, tk * 64, nc0 + tn * 256, nvalid, dst, K, drow0 + tn * 256, mode, tile);
}
constexpr int NT_CONV0 = 2464, NT_CONV = 5472;
__device__ void phase0(const P& p, LAS unsigned char* lds) {
    unsigned char* ws = p.ws;
    const size_t gtid = (size_t)get_bid() * 512 + get_tid(), gsz = (size_t)gridDim.x * 512;
    cvt_rows(p.in[0], (bf16_t*)(ws + W_XB), (size_t)MP * DM, gtid, gsz);
    cvt_rows(p.in[1], (bf16_t*)(ws + W_XB) + (size_t)MP * DM, (size_t)MS * DM, gtid, gsz);
    cvt_rows(p.in[2], (bf16_t*)(ws + W_MEMB), (size_t)1024 * DM, gtid, gsz);
    if (blockIdx.x == 0 && threadIdx.x < 64) {
        const int l = threadIdx.x; float a = p.in[11][l] * p.in[12][l] + p.in[11][l + 64] * p.in[12][l + 64], b = p.in[13][l] * p.in[14][l] + p.in[13][l + 64] * p.in[14][l + 64];
#pragma unroll
        for (int o = 32; o >= 1; o >>= 1) { a += __shfl_xor(a, o); b += __shfl_xor(b, o); }
        if (l == 0) ((float*)(ws + W_MISC))[0] = __expf(a) - __expf(b) + LAM_INIT;
    }
    for (int t = get_bid(); t < NT_CONV0; t += gridDim.x) conv_job(p, t, (LAS float*)lds);
}

DEV void ln_phase(const float* __restrict__ pre, const float* __restrict__ g, const float* __restrict__ b, bf16_t* outb, float* outf, const float* __restrict__ rs, const bf16_t* __restrict__ rsb, const float* __restrict__ ps, int nsplit) {
    const int tid_ = get_tid(), lane = tid_ & 63, gw = get_bid() * 8 + (tid_ >> 6), nw = gridDim.x * 8;
    for (int r = gw; r < MT; r += nw) {
        const float* x = pre + (size_t)r * DM;
        f32x4 v[8]; float s = 0.f;
#pragma unroll
        for (int i = 0; i < 8; ++i) {
            if (r < MP) v[i] = *(const f32x4*)(x + i * 256 + lane * 4);
            else { const size_t o = (size_t)(r - MP) * DM + i * 256 + lane * 4; f32x4 a;
                if (rs) a = *(const f32x4*)(rs + o) * ALPHA; else { const u32x2 xb = *(const u32x2*)(rsb + o); a[0] = bflo(xb.x) * ALPHA; a[1] = bfhi(xb.x) * ALPHA; a[2] = bflo(xb.y) * ALPHA; a[3] = bfhi(xb.y) * ALPHA; }
                for (int k = 0; k < nsplit; ++k) a = a + *(const f32x4*)(ps + (size_t)k * MS * DM + o);
                v[i] = a; }
            s += v[i][0] + v[i][1] + v[i][2] + v[i][3]; }
#pragma unroll
        for (int o = 32; o >= 1; o >>= 1) s += __shfl_xor(s, o);
        const float mu = s * (1.0f / DM); float q = 0.f;
#pragma unroll
        for (int i = 0; i < 8; ++i) { v[i] = v[i] - mu; q += v[i][0] * v[i][0] + v[i][1] * v[i][1] + v[i][2] * v[i][2] + v[i][3] * v[i][3]; }
#pragma unroll
        for (int o = 32; o >= 1; o >>= 1) q += __shfl_xor(q, o);
        const float rs = rsqrtf(q * (1.0f / DM) + 1e-5f);
#pragma unroll
        for (int i = 0; i < 8; ++i) { const int c = i * 256 + lane * 4; const f32x4 gg = *(const f32x4*)(g + c), bb = *(const f32x4*)(b + c);
            const f32x4 y = v[i] * rs * gg + bb;
            if (outf) __builtin_nontemporal_store(y, (f32x4*)(outf + (size_t)r * DM + c));
            if (outb) *(u32x2*)(outb + (size_t)r * DM + c) = pk4(y); }
    }
}

template <int NE, bool BIAS>
DEV void attn_step(const LAS unsigned char* Kl, int KS, const LAS unsigned char* Vl, int VS, const bf16x8 (&qf)[4], f32x4 (&o)[NE], float& m, float& l,
                   float sc2, float sl2, int qpos, int kpos0, int nvalid, int lane) {
    const int fr = lane & 15, g = lane >> 4;
    f32x4 s[4];
    {
        bf16x8 ka[2][4];
#pragma unroll
        for (int ks = 0; ks < 4; ++ks) ka[0][ks] = *(const LAS bf16x8*)(Kl + fr * KS + ks * 64 + g * 16);
#pragma unroll
        for (int kt = 0; kt < 4; ++kt) {
            if (kt < 3) {
#pragma unroll
                for (int ks = 0; ks < 4; ++ks) ka[(kt + 1) & 1][ks] = *(const LAS bf16x8*)(Kl + ((kt + 1) * 16 + fr) * KS + ks * 64 + g * 16);
            }
            __builtin_amdgcn_sched_barrier(0);
            s[kt] = (f32x4){0.f, 0.f, 0.f, 0.f};
#pragma unroll
            for (int ks = 0; ks < 4; ++ks) s[kt] = __builtin_amdgcn_mfma_f32_16x16x32_bf16(ka[kt & 1][ks], qf[ks], s[kt], 0, 0, 0);
            __builtin_amdgcn_sched_barrier(0);
        }
    }
    float mx = -INFINITY;
#pragma unroll
    for (int kt = 0; kt < 4; ++kt)
#pragma unroll
        for (int j = 0; j < 4; ++j) { const int key = kt * 16 + g * 4 + j; float v = s[kt][j] * sc2;
            if (BIAS) v -= sl2 * fabsf((float)(qpos - (kpos0 + key)));
            if (key >= nvalid) v = -INFINITY;
            s[kt][j] = v; mx = fmaxf(mx, v); }
    mx = fmaxf(mx, __shfl_xor(mx, 16)); mx = fmaxf(mx, __shfl_xor(mx, 32));
    const float mn = fmaxf(m, mx), al = ex2(m - mn); m = mn;
    float ps = 0.f;
#pragma unroll
    for (int kt = 0; kt < 4; ++kt)
#pragma unroll
        for (int j = 0; j < 4; ++j) { const float pv = ex2(s[kt][j] - mn); ps += pv; s[kt][j] = pv; }
    l = l * al + ps;
#pragma unroll
    for (int e = 0; e < NE; ++e) o[e] = o[e] * al;
    bf16x8 pb[2];
#pragma unroll
    for (int I = 0; I < 2; ++I) { u32x4 pw; pw.x = pk_bf16(s[2 * I][0], s[2 * I][1]); pw.y = pk_bf16(s[2 * I][2], s[2 * I][3]); pw.z = pk_bf16(s[2 * I + 1][0], s[2 * I + 1][1]); pw.w = pk_bf16(s[2 * I + 1][2], s[2 * I + 1][3]);
        pb[I] = __builtin_bit_cast(bf16x8, pw); }
    constexpr int NG = 2 * NE / 4;
    u32x4 vb[2][4];
#pragma unroll
    for (int q = 0; q < 4; ++q) { const int et = q % NE, I = q / NE; const LAS unsigned char* vp = Vl + (et * 16 + fr) * VS + (32 * I + 4 * g) * 2;
        const u32x2 lo = *(const LAS u32x2*)vp, hi = *(const LAS u32x2*)(vp + 32); vb[0][q] = (u32x4){lo.x, lo.y, hi.x, hi.y}; }
#pragma unroll
    for (int grp = 0; grp < NG; ++grp) {
        if (grp + 1 < NG) {
#pragma unroll
            for (int q = 0; q < 4; ++q) { const int pidx = (grp + 1) * 4 + q, et = pidx % NE, I = pidx / NE; const LAS unsigned char* vp = Vl + (et * 16 + fr) * VS + (32 * I + 4 * g) * 2;
                const u32x2 lo = *(const LAS u32x2*)vp, hi = *(const LAS u32x2*)(vp + 32); vb[(grp + 1) & 1][q] = (u32x4){lo.x, lo.y, hi.x, hi.y}; }
        }
        __builtin_amdgcn_sched_barrier(0);
#pragma unroll
        for (int q = 0; q < 4; ++q) { const int pidx = grp * 4 + q, et = pidx % NE, I = pidx / NE;
            o[et] = __builtin_amdgcn_mfma_f32_16x16x32_bf16(__builtin_bit_cast(bf16x8, vb[grp & 1][q]), pb[I], o[et], 0, 0, 0); }
        __builtin_amdgcn_sched_barrier(0);
    }
}

constexpr int DA_KS = 528, DA_VS = 144, DA_VOFF = 64 * DA_KS;
constexpr float SC2 = 0.08838834764831845f * LOG2E;

template <int NE>
DEV void diff_finalize(f32x4 (&o)[NE], float l, int sm, int slot, int e0, bool cross, float lam, const float* __restrict__ subg, bf16_t* orow, LAS unsigned char* lds, int lane) {
    const int fr = lane & 15, g = lane >> 4;
    LAS float* X = (LAS float*)lds; LAS float* SS = (LAS float*)(lds + 65536);
    l += __shfl_xor(l, 16); l += __shfl_xor(l, 32);
    const float inv = 1.0f / l;
#pragma unroll
    for (int e = 0; e < NE; ++e) o[e] = o[e] * inv;
    __syncthreads();
    if (sm == 1) {
#pragma unroll
        for (int et = 0; et < NE; ++et)
#pragma unroll
            for (int j = 0; j < 4; ++j) X[(slot * NE * 16 + et * 16 + g * 4 + j) * 16 + fr] = o[et][j];
    }
    __syncthreads();
    float ss = 0.f;
    if (sm == 0) {
#pragma unroll
        for (int et = 0; et < NE; ++et)
#pragma unroll
            for (int j = 0; j < 4; ++j) { const float v = o[et][j] - lam * X[(slot * NE * 16 + et * 16 + g * 4 + j) * 16 + fr]; o[et][j] = v; ss += v * v; }
        ss += __shfl_xor(ss, 16); ss += __shfl_xor(ss, 32);
        if (cross && g == 0) SS[slot * 16 + fr] = ss;
    }
    __syncthreads();
    if (sm == 0) {
        if (cross) ss = SS[fr] + SS[16 + fr] + SS[32 + fr] + SS[48 + fr];
        const float r = rsqrtf(ss * (1.0f / 256.0f) + 1e-6f) * (1.0f - LAM_INIT);
#pragma unroll
        for (int et = 0; et < NE; ++et) { const int e = e0 + et * 16 + g * 4; const f32x4 gg = *(const f32x4*)(subg + e);
            f32x4 y = o[et] * r * gg; *(u32x2*)(orow + e) = pk4(y); }
    }
    __syncthreads();
}

DEV void diffattn_prompt_item(const P& p, LAS unsigned char* lds, int b, int h, int c, float lam) {
    const int tid = get_tid(), wid = __builtin_amdgcn_readfirstlane(tid >> 6), lane = tid & 63, fr = lane & 15, g = lane >> 4;
    const int sm = wid & 1, rg = wid >> 1;
    unsigned char* ws = p.ws;
    const bf16_t* QB = (const bf16_t*)(ws + W_QB); const unsigned char* KBp = ws + W_KB; const unsigned char* VTp = ws + W_VT;
    const int qrow = b * SEQ + c * 64 + rg * 16 + fr;
    bf16x8 qf[4];
#pragma unroll
    for (int ks = 0; ks < 4; ++ks) qf[ks] = *(const bf16x8*)(QB + (size_t)qrow * DM + h * 256 + sm * 128 + ks * 32 + g * 8);
    f32x4 o[16];
#pragma unroll
    for (int e = 0; e < 16; ++e) o[e] = (f32x4){0.f, 0.f, 0.f, 0.f};
    float m = -INFINITY, l = 0.f;
    const float sl2 = ex2(-(float)(h + 1)) * LOG2E;
    const unsigned char* kg0 = KBp + ((size_t)(b * SEQ + (tid >> 5)) * DM + h * 256) * 2 + (tid & 31) * 16; const int kl0 = (tid >> 5) * DA_KS + (tid & 31) * 16;
    const unsigned char* vg0 = VTp + ((size_t)((b * 8 + h) * 256 + (tid >> 3)) * SEQ) * 2 + (tid & 7) * 16; const int vl0 = DA_VOFF + (tid >> 3) * DA_VS + (tid & 7) * 16;
    constexpr size_t KGS = (size_t)16 * DM * 2, VGS = (size_t)64 * SEQ * 2; constexpr int KLS = 16 * DA_KS, VLS = 64 * DA_VS;
    u32x4 kreg[4], vreg[4];
#pragma unroll
    for (int i = 0; i < 4; ++i) { kreg[i] = *(const u32x4*)(kg0 + i * KGS); vreg[i] = *(const u32x4*)(vg0 + i * VGS); }
    if (wid >= 4) __builtin_amdgcn_s_setprio(1);
    for (int kt = 0; kt <= c; ++kt) {
        __syncthreads();
#pragma unroll
        for (int i = 0; i < 4; ++i) { *(LAS u32x4*)(lds + kl0 + i * KLS) = kreg[i]; *(LAS u32x4*)(lds + vl0 + i * VLS) = vreg[i]; }
        __syncthreads();
        if (kt < c) {
#pragma unroll
            for (int i = 0; i < 4; ++i) { kreg[i] = *(const u32x4*)(kg0 + i * KGS + (size_t)(kt + 1) * 64 * DM * 2); vreg[i] = *(const u32x4*)(vg0 + i * VGS + (size_t)(kt + 1) * 128); }
        }
        attn_step<16, true>(lds + sm * 256, DA_KS, lds + DA_VOFF, DA_VS, qf, o, m, l, SC2, sl2, c * 64 + rg * 16 + fr, kt * 64, 64, lane);
    }
    __builtin_amdgcn_s_setprio(0);
    bf16_t* orow = (bf16_t*)(ws + W_OA) + (size_t)qrow * DM + h * 256;
    diff_finalize<16>(o, l, sm, rg, 0, false, lam, p.in[15], orow, lds, lane);
}

DEV void diffattn_sample_item(const P& p, LAS unsigned char* lds, int b, int h, float lam) {
    const int tid = get_tid(), wid = __builtin_amdgcn_readfirstlane(tid >> 6), lane = tid & 63, fr = lane & 15, g = lane >> 4;
    const int sm = wid & 1, eq = wid >> 1;
    unsigned char* ws = p.ws;
    const bf16_t* QB = (const bf16_t*)(ws + W_QB); const bf16_t* KBb = (const bf16_t*)(ws + W_KB);
    const float* ck = p.in[3]; const float* cv = p.in[4]; const float* nv = p.out + O_DVS;
    const int qrow = MP + b * ST + fr;
    bf16x8 qf[4];
#pragma unroll
    for (int ks = 0; ks < 4; ++ks) qf[ks] = *(const bf16x8*)(QB + (size_t)qrow * DM + h * 256 + sm * 128 + ks * 32 + g * 8);
    f32x4 o[4];
#pragma unroll
    for (int e = 0; e < 4; ++e) o[e] = (f32x4){0.f, 0.f, 0.f, 0.f};
    float m = -INFINITY, l = 0.f;
    const float sl2 = ex2(-(float)(h + 1)) * LOG2E;
    const int vkey = tid & 63, vseg = tid >> 6;
    const float* kbase = ck + ((size_t)(b * PAST + (tid >> 6)) * 8 + h) * 256 + (tid & 63) * 4;
    const float* vbase = cv + ((size_t)(b * PAST + vkey) * 8 + h) * 256 + vseg * 32;
    constexpr size_t ROWF = 8 * 256;
    f32x4 kr[8], vr[8];
#pragma unroll
    for (int i = 0; i < 8; ++i) { kr[i] = *(const f32x4*)(kbase + (size_t)i * 8 * ROWF); vr[i] = *(const f32x4*)(vbase + i * 4); }
    for (int kt = 0; kt < 16; ++kt) {
        __syncthreads();
#pragma unroll
        for (int i = 0; i < 8; ++i) { const int kr_ = (tid >> 6) + 8 * i, kc = tid & 63;
            *(LAS u32x2*)(lds + kr_ * DA_KS + kc * 8) = pk4(kr[i]);
            const u32x2 pk = pk4(vr[i]); LAS unsigned char* d = lds + DA_VOFF + (vseg * 32 + i * 4) * DA_VS + vkey * 2;
            *(LAS bf16_t*)(d) = (bf16_t)(pk.x & 0xffff); *(LAS bf16_t*)(d + DA_VS) = (bf16_t)(pk.x >> 16); *(LAS bf16_t*)(d + 2 * DA_VS) = (bf16_t)(pk.y & 0xffff); *(LAS bf16_t*)(d + 3 * DA_VS) = (bf16_t)(pk.y >> 16); }
        __syncthreads();
        if (kt < 15) {
#pragma unroll
            for (int i = 0; i < 8; ++i) { kr[i] = *(const f32x4*)(kbase + ((size_t)(kt + 1) * 64 + i * 8) * ROWF); vr[i] = *(const f32x4*)(vbase + (size_t)(kt + 1) * 64 * ROWF + i * 4); }
        }
        attn_step<4, true>(lds + sm * 256, DA_KS, lds + DA_VOFF + eq * 64 * DA_VS, DA_VS, qf, o, m, l, SC2, sl2, PAST + fr, kt * 64, 64, lane);
    }
    {
        __syncthreads();
#pragma unroll
        for (int i = 0; i < 4; ++i) { const int id = tid + 512 * i, kr_ = id >> 5, kc = id & 31;
            u32x4 v = (u32x4){0u, 0u, 0u, 0u};
            if (kr_ < 16) v = *(const u32x4*)(KBb + (size_t)(MP + b * ST + kr_) * DM + h * 256 + kc * 8);
            *(LAS u32x4*)(lds + kr_ * DA_KS + kc * 16) = v; }
        { const float* vp = nv + (size_t)(b * ST + (vkey & 15)) * DM + h * 256 + vseg * 32;
#pragma unroll
          for (int i = 0; i < 8; ++i) { f32x4 v = *(const f32x4*)(vp + i * 4); if (vkey >= 16) v = (f32x4){0.f, 0.f, 0.f, 0.f};
              const u32x2 pk = pk4(v); LAS unsigned char* d = lds + DA_VOFF + (vseg * 32 + i * 4) * DA_VS + vkey * 2;
              *(LAS bf16_t*)(d) = (bf16_t)(pk.x & 0xffff); *(LAS bf16_t*)(d + DA_VS) = (bf16_t)(pk.x >> 16); *(LAS bf16_t*)(d + 2 * DA_VS) = (bf16_t)(pk.y & 0xffff); *(LAS bf16_t*)(d + 3 * DA_VS) = (bf16_t)(pk.y >> 16); } }
        __syncthreads();
        attn_step<4, true>(lds + sm * 256, DA_KS, lds + DA_VOFF + eq * 64 * DA_VS, DA_VS, qf, o, m, l, SC2, sl2, PAST + fr, 16 * 64, 16, lane);
    }
    bf16_t* orow = (bf16_t*)(ws + W_OA) + (size_t)qrow * DM + h * 256;
    diff_finalize<4>(o, l, sm, eq, eq * 64, true, lam, p.in[15], orow, lds, lane);
}

constexpr int XA_KS = 272, XA_VS = 528, XA_VOFF = 256 * XA_KS;
DEV void xattn_prompt_item(const P& p, LAS unsigned char* lds, int b, int h, int tile) {
    const int tid = get_tid(), wid = __builtin_amdgcn_readfirstlane(tid >> 6), lane = tid & 63, fr = lane & 15, g = lane >> 4;
    unsigned char* ws = p.ws;
    const float* QXP = (const float*)(ws + W_QXP); const bf16_t* MK = (const bf16_t*)(ws + W_MEMK); const bf16_t* MVT = (const bf16_t*)(ws + W_MEMVT);
    __syncthreads();
#pragma unroll
    for (int i = 0; i < 8; ++i) { const int id = tid + 512 * i;
        { const int kr = id >> 4, kc = id & 15; *(LAS u32x4*)(lds + kr * XA_KS + kc * 16) = *(const u32x4*)(MK + (size_t)(b * 256 + kr) * 512 + h * 128 + kc * 8); }
        { const int ve = id >> 5, vc = id & 31; *(LAS u32x4*)(lds + XA_VOFF + ve * XA_VS + vc * 16) = *(const u32x4*)(MVT + (size_t)(b * 512 + h * 128 + ve) * 256 + vc * 8); } }
    __syncthreads();
    const int row = b * SEQ + tile * 128 + wid * 16 + fr;
    bf16x8 qf[4];
#pragma unroll
    for (int ks = 0; ks < 4; ++ks) { const float* qp = QXP + (size_t)row * XW + h * 128 + ks * 32 + g * 8; f32x4 a0 = *(const f32x4*)qp, a1 = *(const f32x4*)(qp + 4);
#pragma unroll
        for (int pz = 1; pz < 4; ++pz) { a0 = a0 + *(const f32x4*)(qp + (size_t)pz * MT * XW); a1 = a1 + *(const f32x4*)(qp + (size_t)pz * MT * XW + 4); }
        u32x4 w; w.x = pk_bf16(a0[0], a0[1]); w.y = pk_bf16(a0[2], a0[3]); w.z = pk_bf16(a1[0], a1[1]); w.w = pk_bf16(a1[2], a1[3]); qf[ks] = __builtin_bit_cast(bf16x8, w); }
    f32x4 o[8];
#pragma unroll
    for (int e = 0; e < 8; ++e) o[e] = (f32x4){0.f, 0.f, 0.f, 0.f};
    float m = -INFINITY, l = 0.f;
#pragma unroll 1
    for (int kt = 0; kt < 4; ++kt)
        attn_step<8, false>(lds + kt * 64 * XA_KS, XA_KS, lds + XA_VOFF + kt * 128, XA_VS, qf, o, m, l, SC2, 0.f, 0, 0, 64, lane);
    l += __shfl_xor(l, 16); l += __shfl_xor(l, 32);
    const float inv = 1.0f / l;
    bf16_t* orow = (bf16_t*)(ws + W_OX) + (size_t)row * XW + h * 128;
#pragma unroll
    for (int et = 0; et < 8; ++et) *(u32x2*)(orow + et * 16 + g * 4) = pk4(o[et] * inv);
}
DEV void xattn_sample_item(const P& p, LAS unsigned char* lds, int b, int h) {
    const int tid = get_tid(), wid = __builtin_amdgcn_readfirstlane(tid >> 6), lane = tid & 63, fr = lane & 15, g = lane >> 4;
    unsigned char* ws = p.ws;
    const float* QXP = (const float*)(ws + W_QXP); const float* mk = p.in[7]; const float* mv = p.in[8];
    __syncthreads();
#pragma unroll
    for (int i = 0; i < 16; ++i) { const int id = tid + 512 * i, kr = id >> 5, kc = id & 31;
        const f32x4 v = *(const f32x4*)(mk + ((size_t)(b * 256 + kr) * 4 + h) * 128 + kc * 4);
        *(LAS u32x2*)(lds + kr * XA_KS + kc * 8) = pk4(v);
        const f32x4 w = *(const f32x4*)(mv + ((size_t)(b * 256 + kr) * 4 + h) * 128 + kc * 4); const u32x2 pk = pk4(w);
        LAS unsigned char* d = lds + XA_VOFF + (kc * 4) * XA_VS + kr * 2;
        *(LAS bf16_t*)(d) = (bf16_t)(pk.x & 0xffff); *(LAS bf16_t*)(d + XA_VS) = (bf16_t)(pk.x >> 16); *(LAS bf16_t*)(d + 2 * XA_VS) = (bf16_t)(pk.y & 0xffff); *(LAS bf16_t*)(d + 3 * XA_VS) = (bf16_t)(pk.y >> 16); }
    __syncthreads();
    if (wid == 0) {
        const int row = MP + b * ST + fr;
        bf16x8 qf[4];
#pragma unroll
        for (int ks = 0; ks < 4; ++ks) { const float* qp = QXP + (size_t)row * XW + h * 128 + ks * 32 + g * 8; f32x4 a0 = *(const f32x4*)qp, a1 = *(const f32x4*)(qp + 4);
#pragma unroll
        for (int pz = 1; pz < 4; ++pz) { a0 = a0 + *(const f32x4*)(qp + (size_t)pz * MT * XW); a1 = a1 + *(const f32x4*)(qp + (size_t)pz * MT * XW + 4); }
        u32x4 w; w.x = pk_bf16(a0[0], a0[1]); w.y = pk_bf16(a0[2], a0[3]); w.z = pk_bf16(a1[0], a1[1]); w.w = pk_bf16(a1[2], a1[3]); qf[ks] = __builtin_bit_cast(bf16x8, w); }
        f32x4 o[8];
#pragma unroll
        for (int e = 0; e < 8; ++e) o[e] = (f32x4){0.f, 0.f, 0.f, 0.f};
        float m = -INFINITY, l = 0.f;
#pragma unroll 1
        for (int kt = 0; kt < 4; ++kt)
            attn_step<8, false>(lds + kt * 64 * XA_KS, XA_KS, lds + XA_VOFF + kt * 128, XA_VS, qf, o, m, l, SC2, 0.f, 0, 0, 64, lane);
        l += __shfl_xor(l, 16); l += __shfl_xor(l, 32);
        const float inv = 1.0f / l;
        bf16_t* orow = (bf16_t*)(ws + W_OX) + (size_t)row * XW + h * 128;
#pragma unroll
        for (int et = 0; et < 8; ++et) *(u32x2*)(orow + et * 16 + g * 4) = pk4(o[et] * inv);
    }
}

constexpr int GA_QS = 512, GA_KS = 17920, GA_MS = 35328, GA_RHS = 51712;
constexpr float QSCALE = 0.08838834764831845f;

DEV void conv16(const P& p, bool sample, int b, int tseq, int rowbase, int ch, float (&acc)[16]) {
    const bf16_t* GB = (const bf16_t*)(p.ws + W_GB); const float* cw = p.in[10]; const float* cbuf = p.in[6];
#pragma unroll
    for (int i = 0; i < 16; ++i) acc[i] = 0.f;
#pragma unroll 1
    for (int j = 0; j < 4; ++j) { const int tt = tseq - 3 + j;
        float x[16];
        if (tt >= 0) { const u32x4 a = *(const u32x4*)(GB + (size_t)(rowbase + tt) * 6144 + ch), c = *(const u32x4*)(GB + (size_t)(rowbase + tt) * 6144 + ch + 8);
            x[0] = bflo(a.x); x[1] = bfhi(a.x); x[2] = bflo(a.y); x[3] = bfhi(a.y); x[4] = bflo(a.z); x[5] = bfhi(a.z); x[6] = bflo(a.w); x[7] = bfhi(a.w);
            x[8] = bflo(c.x); x[9] = bfhi(c.x); x[10] = bflo(c.y); x[11] = bfhi(c.y); x[12] = bflo(c.z); x[13] = bfhi(c.z); x[14] = bflo(c.w); x[15] = bfhi(c.w);
        } else if (sample) { const float* s = cbuf + ((size_t)b * 3 + (3 + tt)) * 6144 + ch;
#pragma unroll
            for (int q = 0; q < 4; ++q) { const f32x4 v = *(const f32x4*)(s + q * 4); x[q * 4] = v[0]; x[q * 4 + 1] = v[1]; x[q * 4 + 2] = v[2]; x[q * 4 + 3] = v[3]; }
        } else {
#pragma unroll
            for (int i = 0; i < 16; ++i) x[i] = 0.f;
        }
#pragma unroll
        for (int q = 0; q < 4; ++q) { const f32x4 w = *(const f32x4*)(cw + (size_t)j * 6144 + ch + q * 4);
            acc[q * 4] += w[0] * x[q * 4]; acc[q * 4 + 1] += w[1] * x[q * 4 + 1]; acc[q * 4 + 2] += w[2] * x[q * 4 + 2]; acc[q * 4 + 3] += w[3] * x[q * 4 + 3]; }
    }
#pragma unroll
    for (int i = 0; i < 16; ++i) acc[i] = siluf_(acc[i]);
}

constexpr int GA_XRAW = GA_MS, GA_XS = 784, GA_WL = 117248;
DEV void conv16_lds(const LAS unsigned char* lds, int tensor, int t, int d0, float (&acc)[16]) {
#pragma unroll
    for (int i = 0; i < 16; ++i) acc[i] = 0.f;
#pragma unroll
    for (int j = 0; j < 4; ++j) {
        const LAS unsigned char* xp = lds + GA_XRAW + (t + j) * GA_XS + tensor * 256 + d0 * 2;
        const u32x4 a = *(const LAS u32x4*)xp, c = *(const LAS u32x4*)(xp + 16);
        const float x[16] = {bflo(a.x), bfhi(a.x), bflo(a.y), bfhi(a.y), bflo(a.z), bfhi(a.z), bflo(a.w), bfhi(a.w), bflo(c.x), bfhi(c.x), bflo(c.y), bfhi(c.y), bflo(c.z), bfhi(c.z), bflo(c.w), bfhi(c.w)};
        const LAS float* wp = (const LAS float*)(lds + GA_WL) + (tensor * 4 + j) * 128 + d0;
#pragma unroll
        for (int q = 0; q < 4; ++q) { const f32x4 w = *(const LAS f32x4*)(wp + q * 4);
            acc[q * 4] += w[0] * x[q * 4]; acc[q * 4 + 1] += w[1] * x[q * 4 + 1]; acc[q * 4 + 2] += w[2] * x[q * 4 + 2]; acc[q * 4 + 3] += w[3] * x[q * 4 + 3]; }
    }
#pragma unroll
    for (int i = 0; i < 16; ++i) acc[i] = siluf_(acc[i]);
}

template <int C>
DEV void gdn_a_item(const P& p, LAS unsigned char* lds, bool sample, int b, int n, int h, unsigned char* item, float* decp) {
    constexpr int CP = C < 32 ? 32 : C;
    constexpr size_t OFF_W = 0, OFF_UT = (size_t)C * 256, OFF_QG = (size_t)C * 512, OFF_QK = (size_t)C * 768, OFF_KDT = OFF_QK + (size_t)C * CP * 2;
    const int tid = get_tid(), wid = __builtin_amdgcn_readfirstlane(tid >> 6), lane = tid & 63, fr = lane & 15, g = lane >> 4;
    LAS float* GC = (LAS float*)lds; LAS float* BETA = (LAS float*)(lds + 256);
    LAS float* Ms = (LAS float*)(lds + GA_MS); LAS float* RHS = (LAS float*)(lds + GA_RHS);
    const int rowbase = sample ? MP + b * ST : b * SEQ;
    const int t0 = sample ? 0 : n * 64;
    __syncthreads();
    {
        const bf16_t* GB = (const bf16_t*)(p.ws + W_GB);
        constexpr int NCH = (C + 3) * 48, NIT = (NCH + 511) / 512;
        u32x4 sv[NIT];
#pragma unroll
        for (int k = 0; k < NIT; ++k) { const int id = tid + 512 * k; sv[k] = (u32x4){0u, 0u, 0u, 0u};
            if (id < NCH) { const int r = id / 48, c = id % 48, tensor = c >> 4, cc = c & 15; const int tt = t0 - 3 + r;
                const int ch = tensor * 2048 + h * 128 + cc * 8;
                if (tt >= 0) sv[k] = *(const u32x4*)(GB + (size_t)(rowbase + tt) * 6144 + ch);
                else if (sample) { const float* sp = p.in[6] + ((size_t)b * 3 + (3 + tt)) * 6144 + ch; const f32x4 f0 = *(const f32x4*)sp, f1 = *(const f32x4*)(sp + 4);
                    sv[k].x = pk_bf16(f0[0], f0[1]); sv[k].y = pk_bf16(f0[2], f0[3]); sv[k].z = pk_bf16(f1[0], f1[1]); sv[k].w = pk_bf16(f1[2], f1[3]); } } }
#pragma unroll
        for (int k = 0; k < NIT; ++k) { const int id = tid + 512 * k;
            if (id < NCH) { const int r = id / 48, c = id % 48, tensor = c >> 4, cc = c & 15; *(LAS u32x4*)(lds + GA_XRAW + r * GA_XS + tensor * 256 + cc * 16) = sv[k]; } }
        if (tid < 384) { const int tensor = tid >> 7, rem = tid & 127, j = rem >> 5, d4 = (rem & 31) * 4;
            *(LAS f32x4*)(lds + GA_WL + ((tensor * 4 + j) * 128 + d4) * 4) = *(const f32x4*)(p.in[10] + (size_t)j * 6144 + tensor * 2048 + h * 128 + d4); }
    }
    if (tid < 64) {
        float gv = 0.f, bt = 0.f;
        if (tid < C) { const float* gab = (const float*)(p.ws + W_GAB) + (size_t)(rowbase + t0 + tid) * 32;
            const float ga = gab[h] + p.in[17][h], gb = gab[16 + h];
            const float sp = ga > 20.f ? ga : log1pf(__expf(ga));
            gv = -__expf(p.in[16][h]) * sp; bt = sigmoidf_(gb); }
#pragma unroll
        for (int o = 1; o < 64; o <<= 1) { const float u = __shfl_up(gv, o); if (lane >= o) gv += u; }
        if (tid < C) { GC[tid] = gv; BETA[tid] = bt; }
    }
    __syncthreads();
    const int t = tid >> 3, part = tid & 7;
    const int d0 = part * 16;
    float q[16], k[16], v[16];
    if (t < C) {
        conv16_lds(lds, 0, t, d0, q);
        conv16_lds(lds, 1, t, d0, k);
        conv16_lds(lds, 2, t, d0, v);
    }
    __syncthreads();
    if (t < C) {
        const float gcv = GC[t], beta = BETA[t], glast = GC[C - 1];
        float sq = 0.f, sk = 0.f;
#pragma unroll
        for (int i = 0; i < 16; ++i) { sq += q[i] * q[i]; sk += k[i] * k[i]; }
#pragma unroll
        for (int o = 1; o < 8; o <<= 1) { sq += __shfl_xor(sq, o); sk += __shfl_xor(sk, o); }
        const float rq = rsqrtf(sq + 1e-6f) * QSCALE, rk = rsqrtf(sk + 1e-6f);
        const float eg = __expf(gcv), ekd = __expf(glast - gcv);
#pragma unroll
        for (int i = 0; i < 16; ++i) { q[i] *= rq; k[i] *= rk; }
        u32x4 w0, w1;
        w0.x = pk_bf16(q[0], q[1]); w0.y = pk_bf16(q[2], q[3]); w0.z = pk_bf16(q[4], q[5]); w0.w = pk_bf16(q[6], q[7]);
        w1.x = pk_bf16(q[8], q[9]); w1.y = pk_bf16(q[10], q[11]); w1.z = pk_bf16(q[12], q[13]); w1.w = pk_bf16(q[14], q[15]);
        *(LAS u32x4*)(lds + GA_QS + t * 272 + d0 * 2) = w0; *(LAS u32x4*)(lds + GA_QS + t * 272 + d0 * 2 + 16) = w1;
        w0.x = pk_bf16(k[0], k[1]); w0.y = pk_bf16(k[2], k[3]); w0.z = pk_bf16(k[4], k[5]); w0.w = pk_bf16(k[6], k[7]);
        w1.x = pk_bf16(k[8], k[9]); w1.y = pk_bf16(k[10], k[11]); w1.z = pk_bf16(k[12], k[13]); w1.w = pk_bf16(k[14], k[15]);
        *(LAS u32x4*)(lds + GA_KS + t * 272 + d0 * 2) = w0; *(LAS u32x4*)(lds + GA_KS + t * 272 + d0 * 2 + 16) = w1;
        w0.x = pk_bf16(q[0] * eg, q[1] * eg); w0.y = pk_bf16(q[2] * eg, q[3] * eg); w0.z = pk_bf16(q[4] * eg, q[5] * eg); w0.w = pk_bf16(q[6] * eg, q[7] * eg);
        w1.x = pk_bf16(q[8] * eg, q[9] * eg); w1.y = pk_bf16(q[10] * eg, q[11] * eg); w1.z = pk_bf16(q[12] * eg, q[13] * eg); w1.w = pk_bf16(q[14] * eg, q[15] * eg);
        *(u32x4*)(item + OFF_QG + ((size_t)t * 128 + d0) * 2) = w0; *(u32x4*)(item + OFF_QG + ((size_t)t * 128 + d0) * 2 + 16) = w1;
        bf16_t* kdt = (bf16_t*)(item + OFF_KDT);
        const float bg = beta * eg;
#pragma unroll
        for (int i = 0; i < 16; ++i) { kdt[(size_t)(d0 + i) * CP + t] = (bf16_t)(pk_bf16(k[i] * ekd, 0.f) & 0xffff);
            RHS[t * 256 + d0 + i] = v[i] * beta; RHS[t * 256 + 128 + d0 + i] = k[i] * bg; }
    } else if (C < CP && t < CP) {
        bf16_t* kdt = (bf16_t*)(item + OFF_KDT);
#pragma unroll
        for (int i = 0; i < 16; ++i) kdt[(size_t)(part * 16 + i) * CP + t] = 0;
    }
    if (C < CP) { bf16_t* qk = (bf16_t*)(item + OFF_QK); for (int idx = tid; idx < C * (CP - C); idx += 512) qk[(idx / (CP - C)) * CP + C + idx % (CP - C)] = 0; }
    if (tid == 0) *decp = __expf(GC[C - 1]);
    __syncthreads();
    constexpr int NTI = C / 16, NTL = NTI * NTI * 2;
    for (int id = wid; id < NTL; id += 8) {
        const int which = id / (NTI * NTI), it = (id / NTI) % NTI, jt = id % NTI;
        const LAS unsigned char* Ab = lds + (which ? GA_QS : GA_KS) + (it * 16 + fr) * 272 + g * 16;
        const LAS unsigned char* Bb = lds + GA_KS + (jt * 16 + fr) * 272 + g * 16;
        f32x4 d = (f32x4){0.f, 0.f, 0.f, 0.f};
#pragma unroll
        for (int ks = 0; ks < 4; ++ks) d = __builtin_amdgcn_mfma_f32_16x16x32_bf16(*(const LAS bf16x8*)(Ab + ks * 64), *(const LAS bf16x8*)(Bb + ks * 64), d, 0, 0, 0);
        const int j = jt * 16 + fr; const float gj = GC[j];
#pragma unroll
        for (int jj = 0; jj < 4; ++jj) { const int i = it * 16 + g * 4 + jj; const float dec = __expf(GC[i] - gj);
            if (which == 0) Ms[i * C + j] = (i > j) ? BETA[i] * d[jj] * dec : 0.f;
            else ((bf16_t*)(item + OFF_QK))[(size_t)i * CP + j] = (bf16_t)(pk_bf16((i >= j) ? d[jj] * dec : 0.f, 0.f) & 0xffff); }
    }
    __syncthreads();
    if (tid < 256) {
        float s[C];
#pragma unroll
        for (int i = 0; i < C; ++i) s[i] = 0.f;
#pragma unroll
        for (int i = 0; i < C; ++i) { float a = RHS[i * 256 + tid];
#pragma unroll
            for (int j4 = 0; j4 < (i + 3) / 4; ++j4) { const f32x4 mv = *(const LAS f32x4*)(Ms + i * C + j4 * 4);
                a -= mv[0] * s[j4 * 4] + mv[1] * s[j4 * 4 + 1] + mv[2] * s[j4 * 4 + 2] + mv[3] * s[j4 * 4 + 3]; }
            s[i] = a; }
        if (tid < 128) { unsigned char* ut = item + OFF_UT + (size_t)tid * C * 2;
#pragma unroll
            for (int i = 0; i < C; i += 8) { u32x4 w; w.x = pk_bf16(s[i], s[i + 1]); w.y = pk_bf16(s[i + 2], s[i + 3]); w.z = pk_bf16(s[i + 4], s[i + 5]); w.w = pk_bf16(s[i + 6], s[i + 7]); *(u32x4*)(ut + i * 2) = w; }
        } else { bf16_t* wp = (bf16_t*)(item + OFF_W) + (tid - 128);
#pragma unroll
            for (int i = 0; i < C; ++i) wp[(size_t)i * 128] = (bf16_t)(pk_bf16(s[i], 0.f) & 0xffff); }
    }
}

constexpr int GB_W = 0, GB_QG = 17408, GB_QK = 34816, GB_KDT = 44032, GB_ST = 62464, GB_VNT = 97280, GB_OS = 115712;
template <int C>
DEV void gdn_scan_chain(const P& p, LAS unsigned char* lds, bool sample, int b, int h) {
    constexpr int CP = C < 32 ? 32 : C, RS = CP * 2 + 16, NCT = C / 16, NKK = CP / 32;
    constexpr size_t OFF_W = 0, OFF_UT = (size_t)C * 256, OFF_QG = (size_t)C * 512, OFF_QK = (size_t)C * 768, OFF_KDT = OFF_QK + (size_t)C * CP * 2, ISZ = OFF_KDT + (size_t)128 * CP * 2;
    const int tid = get_tid(), wid = __builtin_amdgcn_readfirstlane(tid >> 6), lane = tid & 63, fr = lane & 15, g = lane >> 4;
    const int et = wid, e = et * 16 + fr;
    unsigned char* ws = p.ws;
    f32x4 sreg[8];
    __syncthreads();
    for (int i = tid; i < 128 * RS / 4; i += 512) ((LAS unsigned*)(lds + GB_VNT))[i] = 0u;
    if (sample) { const float* s0 = p.in[5] + (size_t)(b * 16 + h) * 16384;
#pragma unroll
        for (int dt = 0; dt < 8; ++dt)
#pragma unroll
            for (int j = 0; j < 4; ++j) sreg[dt][j] = s0[(size_t)(dt * 16 + g * 4 + j) * 128 + e];
    } else {
#pragma unroll
        for (int dt = 0; dt < 8; ++dt) sreg[dt] = (f32x4){0.f, 0.f, 0.f, 0.f};
    }
#pragma unroll
    for (int dt = 0; dt < 8; ++dt) *(LAS u32x2*)(lds + GB_ST + e * 272 + (dt * 16 + g * 4) * 2) = pk4(sreg[dt]);
    const int nchunk = sample ? 1 : 32;
    for (int n = 0; n < nchunk; ++n) {
        const int itemi = sample ? (b * 16 + h) : ((b * 32 + n) * 16 + h);
        const unsigned char* item = sample ? ws + W_GDNS + (size_t)itemi * ISZ : ws + W_GDN + (size_t)itemi * ISZ;
        const float dec = __hip_atomic_load((const float*)(ws + W_DEC) + (sample ? 2048 + itemi : itemi), __ATOMIC_RELAXED, __HIP_MEMORY_SCOPE_AGENT);
        const int row0 = sample ? MP + b * ST : b * SEQ + n * 64;
        __syncthreads();
        for (int id = tid; id < C * 16; id += 512) { const int r = id >> 4, c = id & 15;
            *(LAS u32x4*)(lds + GB_W + r * 272 + c * 16) = *(const u32x4*)(item + OFF_W + (size_t)r * 256 + c * 16);
            *(LAS u32x4*)(lds + GB_QG + r * 272 + c * 16) = *(const u32x4*)(item + OFF_QG + (size_t)r * 256 + c * 16); }
        for (int id = tid; id < C * (CP / 8); id += 512) { const int r = id / (CP / 8), c = id % (CP / 8);
            *(LAS u32x4*)(lds + GB_QK + r * RS + c * 16) = *(const u32x4*)(item + OFF_QK + (size_t)r * CP * 2 + c * 16); }
        for (int id = tid; id < 128 * (CP / 8); id += 512) { const int r = id / (CP / 8), c = id % (CP / 8);
            *(LAS u32x4*)(lds + GB_KDT + r * RS + c * 16) = *(const u32x4*)(item + OFF_KDT + (size_t)r * CP * 2 + c * 16); }
        u32x2 uu[NCT];
#pragma unroll
        for (int ct = 0; ct < NCT; ++ct) uu[ct] = *(const u32x2*)(item + OFF_UT + ((size_t)e * C + ct * 16 + g * 4) * 2);
        __syncthreads();
        bf16x8 sf[4];
#pragma unroll
        for (int ks = 0; ks < 4; ++ks) sf[ks] = *(const LAS bf16x8*)(lds + GB_ST + e * 272 + ks * 64 + g * 16);
#pragma unroll
        for (int ct = 0; ct < NCT; ++ct) { f32x4 d = (f32x4){0.f, 0.f, 0.f, 0.f};
#pragma unroll
            for (int ks = 0; ks < 4; ++ks) d = __builtin_amdgcn_mfma_f32_16x16x32_bf16(*(const LAS bf16x8*)(lds + GB_W + (ct * 16 + fr) * 272 + ks * 64 + g * 16), sf[ks], d, 0, 0, 0);
            f32x4 vn; vn[0] = bflo(uu[ct].x) - d[0]; vn[1] = bfhi(uu[ct].x) - d[1]; vn[2] = bflo(uu[ct].y) - d[2]; vn[3] = bfhi(uu[ct].y) - d[3];
            *(LAS u32x2*)(lds + GB_VNT + e * RS + (ct * 16 + g * 4) * 2) = pk4(vn); }
        __syncthreads();
        bf16x8 vf[NKK];
#pragma unroll
        for (int kk = 0; kk < NKK; ++kk) vf[kk] = *(const LAS bf16x8*)(lds + GB_VNT + e * RS + kk * 64 + g * 16);
#pragma unroll
        for (int ct = 0; ct < NCT; ++ct) { f32x4 d = (f32x4){0.f, 0.f, 0.f, 0.f};
#pragma unroll
            for (int ks = 0; ks < 4; ++ks) d = __builtin_amdgcn_mfma_f32_16x16x32_bf16(*(const LAS bf16x8*)(lds + GB_QG + (ct * 16 + fr) * 272 + ks * 64 + g * 16), sf[ks], d, 0, 0, 0);
#pragma unroll
            for (int kk = 0; kk < NKK; ++kk) d = __builtin_amdgcn_mfma_f32_16x16x32_bf16(*(const LAS bf16x8*)(lds + GB_QK + (ct * 16 + fr) * RS + kk * 64 + g * 16), vf[kk], d, 0, 0, 0);
#pragma unroll
            for (int j = 0; j < 4; ++j) ((LAS bf16_t*)(lds + GB_W))[(ct * 16 + g * 4 + j) * 136 + e] = (bf16_t)(pk_bf16(d[j], 0.f) & 0xffff); }
#pragma unroll
        for (int dt = 0; dt < 8; ++dt) { f32x4 d = sreg[dt] * dec;
#pragma unroll
            for (int kk = 0; kk < NKK; ++kk) d = __builtin_amdgcn_mfma_f32_16x16x32_bf16(*(const LAS bf16x8*)(lds + GB_KDT + (dt * 16 + fr) * RS + kk * 64 + g * 16), vf[kk], d, 0, 0, 0);
            sreg[dt] = d; }
        __syncthreads();
#pragma unroll
        for (int dt = 0; dt < 8; ++dt) *(LAS u32x2*)(lds + GB_ST + e * 272 + (dt * 16 + g * 4) * 2) = pk4(sreg[dt]);
        { const int t = tid >> 3, part = tid & 7;
          if (t < C) { const LAS unsigned char* op = lds + GB_W + t * 272 + part * 32; float ov[16]; float ss = 0.f;
              const u32x4 o0 = *(const LAS u32x4*)op, o1 = *(const LAS u32x4*)(op + 16);
              const unsigned owd[8] = {o0.x, o0.y, o0.z, o0.w, o1.x, o1.y, o1.z, o1.w};
#pragma unroll
              for (int i = 0; i < 8; ++i) { ov[2 * i] = bflo(owd[i]); ov[2 * i + 1] = bfhi(owd[i]); }
#pragma unroll
              for (int i = 0; i < 16; ++i) ss += ov[i] * ov[i];
#pragma unroll
              for (int o = 1; o < 8; o <<= 1) ss += __shfl_xor(ss, o);
              const float r = rsqrtf(ss * (1.0f / 128.0f) + 1e-6f);
              const size_t off = (size_t)(row0 + t) * DM + h * 128 + part * 16;
              const bf16_t* Z = (const bf16_t*)(ws + W_ZB) + off; const float* gn = p.in[18] + part * 16;
              const u32x4 z0 = *(const u32x4*)Z, z1 = *(const u32x4*)(Z + 8);
              const unsigned zw[8] = {z0.x, z0.y, z0.z, z0.w, z1.x, z1.y, z1.z, z1.w};
              unsigned ow[8];
#pragma unroll
              for (int i = 0; i < 8; ++i) { const float a = ov[2 * i] * r * gn[2 * i] * siluf_(bflo(zw[i])), c2 = ov[2 * i + 1] * r * gn[2 * i + 1] * siluf_(bfhi(zw[i])); ow[i] = pk_bf16(a, c2); }
              bf16_t* O = (bf16_t*)(ws + W_OB) + off;
              *(u32x4*)O = (u32x4){ow[0], ow[1], ow[2], ow[3]}; *(u32x4*)(O + 8) = (u32x4){ow[4], ow[5], ow[6], ow[7]}; } }
        __syncthreads();
    }
    float* so = p.out + (sample ? O_GSS : O_GSP) + (size_t)(b * 16 + h) * 16384;
#pragma unroll
    for (int dt = 0; dt < 8; ++dt)
#pragma unroll
        for (int j = 0; j < 4; ++j) so[(size_t)(dt * 16 + g * 4 + j) * 128 + e] = sreg[dt][j];
}

#define XB_TMO      128
#define XB_XCNT(j)  (256  + 64 * (j))
#define XB_XSUB(j)  (1280 + 64 * (j))
#define XB_XGEN(j)  (2304 + 64 * (j))
#define XB_TOP      3328
#define XB_TOPGEN   3392
#define XB_SPIN_CAP (1u << 18)
DEV unsigned xb_ld(unsigned* p)              { return __hip_atomic_load(p, __ATOMIC_RELAXED, __HIP_MEMORY_SCOPE_AGENT); }
DEV unsigned xb_add(unsigned* p, unsigned v) { return __hip_atomic_fetch_add(p, v, __ATOMIC_RELAXED, __HIP_MEMORY_SCOPE_AGENT); }
DEV unsigned xb_xcc_id() { return (unsigned)__builtin_amdgcn_s_getreg((3 << 11) | 20) & 0xFu; }
#define XB_SPIN(cond, bar) do { unsigned _sp = 0; while (cond) { __builtin_amdgcn_s_sleep(1); \
    if ((++_sp & 255u) == 0u) { if (xb_ld(&(bar)[XB_TMO])) break; if (_sp > XB_SPIN_CAP) { atomicAdd(&(bar)[XB_TMO], 1u); break; } } } } while (0)
struct XcdBarrier { unsigned* bar; unsigned x; volatile LAS unsigned* st; };
DEV XcdBarrier xcd_barrier_post(unsigned* bar, volatile LAS unsigned* st) {
    XcdBarrier b; b.bar = bar; b.x = xb_xcc_id(); b.st = st;
    if (threadIdx.x == 0) (void)xb_add(&bar[XB_XCNT(b.x)], 1u);
    return b;
}
DEV void xcd_barrier_complete(unsigned* bar, unsigned x, unsigned& nloc, unsigned& nx) {
    const unsigned G = gridDim.x * gridDim.y * gridDim.z;
    unsigned sum, cnt, mine, sp = 0u;
    for (;;) {
        sum = 0u; cnt = 0u; mine = 0u;
#pragma unroll
        for (unsigned j = 0; j < 16; ++j) { const unsigned c = xb_ld(&bar[XB_XCNT(j)]); sum += c; cnt += (c > 0u) ? 1u : 0u; mine = (j == x) ? c : mine; }
        if (sum == G) break;
        __builtin_amdgcn_s_sleep(1);
        if ((++sp & 255u) == 0u) { if (xb_ld(&bar[XB_TMO])) break; if (sp > XB_SPIN_CAP) { atomicAdd(&bar[XB_TMO], 1u); break; } }
    }
    nloc = mine > 0u ? mine : 1u; nx = cnt > 0u ? cnt : 1u;
}
DEV void xcd_barrier(const XcdBarrier& b) {
    asm volatile("s_waitcnt vmcnt(0)" ::: "memory");
    __syncthreads();
    if (threadIdx.x == 0) {
        unsigned* bar = b.bar;
        __builtin_amdgcn_s_waitcnt(0);
        unsigned nloc = b.st[0], nx = b.st[1];
        if (nloc == 0u) { xcd_barrier_complete(bar, b.x, nloc, nx); b.st[0] = nloc; b.st[1] = nx; }
        const unsigned old = xb_add(&bar[XB_XSUB(b.x)], 1u);
        const unsigned gen = old / nloc;
        if (old + 1u == (gen + 1u) * nloc) {
            __builtin_amdgcn_fence(__ATOMIC_RELEASE, "agent");
            asm volatile("s_waitcnt vmcnt(0)" ::: "memory");
            const unsigned og = xb_add(&bar[XB_TOP], 1u);
            const unsigned tg = og / nx;
            if (og + 1u == (tg + 1u) * nx) xb_add(&bar[XB_TOPGEN], 1u);
            else XB_SPIN(xb_ld(&bar[XB_TOPGEN]) == tg, bar);
            __builtin_amdgcn_fence(__ATOMIC_ACQUIRE, "agent");
            xb_add(&bar[XB_XGEN(b.x)], 1u);
            asm volatile("s_waitcnt vmcnt(0)" ::: "memory");
        } else {
            XB_SPIN(xb_ld(&bar[XB_XGEN(b.x)]) == gen, bar);
            __builtin_amdgcn_fence(__ATOMIC_ACQUIRE, "agent");
            asm volatile("s_waitcnt vmcnt(0)" ::: "memory");
        }
    }
    __syncthreads();
}

#ifndef MK_PER_PHASE
#define MK_PER_PHASE 0
#endif
constexpr int NPHASE = 14;
#ifndef PH_MASK
#define PH_MASK 0xffff
#endif
#define PH_ON(k) ((PH_MASK >> (k)) & 1)

DEV int queue_pop(int* ctr, LAS unsigned char* lds) {
    __syncthreads();
    if (get_tid() == 0) *(LAS int*)(lds + LDS_BYTES - 16) = atomicAdd(ctr, 1);
    __syncthreads();
    return *(LAS int*)(lds + LDS_BYTES - 16);
}
DEV void phase_fn0(const P* pp, LAS unsigned char* lds) {
    const P& p = *pp; unsigned char* ws = p.ws; const int bid = get_bid(), G = gridDim.x; (void)ws; (void)bid; (void)G;
        phase0(p, lds);
}
DEV void phase_fn1(const P* pp, LAS unsigned char* lds) {
    const P& p = *pp; unsigned char* ws = p.ws; const int bid = get_bid(), G = gridDim.x; (void)ws; (void)bid; (void)G;
        EpiProj e1; e1.ws = ws; e1.out = p.out;
        run_gemm(lds, (const bf16_t*)(ws + W_XB), (const bf16_t*)(ws + W_WIN), MT, NPROJ, DM, e1, bid);
        EpiMemKV e2; e2.ws = ws; e2.out = p.out;
        run_gemm(lds, (const bf16_t*)(ws + W_MEMB), (const bf16_t*)(ws + W_WXKV), 1024, 1024, DM, e2, G - 1 - bid);
        for (;;) { const int q = queue_pop((int*)(ws + W_MISC + 200), lds); if (q >= NT_CONV - NT_CONV0) break; conv_job(p, NT_CONV0 + q, (LAS float*)lds); }
}
DEV void phase_fn2(const P* pp, LAS unsigned char* lds) {
    const P& p = *pp; unsigned char* ws = p.ws;
    const float lam = __hip_atomic_load((const float*)(ws + W_MISC), __ATOMIC_RELAXED, __HIP_MEMORY_SCOPE_AGENT);
    int* qctr = (int*)(ws + W_MISC + 192);
    for (;;) {
        const int q = queue_pop(qctr, lds);
        if (q >= 128 + 2304) break;
        if (q < 128) diffattn_sample_item(p, lds, q >> 3, q & 7, lam);
        else { const int it = q - 128;
            if (it < 2048) gdn_a_item<64>(p, lds, false, it >> 9, (it >> 4) & 31, it & 15, ws + W_GDN + (size_t)it * GP_SZ, (float*)(ws + W_DEC) + it);
            else { const int s = it - 2048; gdn_a_item<16>(p, lds, true, s >> 4, 0, s & 15, ws + W_GDN + (size_t)2048 * GP_SZ + (size_t)s * GS_SZ, (float*)(ws + W_DEC) + it); } }
    }
}
DEV void phase_fn3(const P* pp, LAS unsigned char* lds) {
    const P& p = *pp; unsigned char* ws = p.ws;
    const float lam = __hip_atomic_load((const float*)(ws + W_MISC), __ATOMIC_RELAXED, __HIP_MEMORY_SCOPE_AGENT);
    int* qctr = (int*)(ws + W_MISC + 196);
    for (;;) {
        const int q = queue_pop(qctr, lds);
        if (q >= 64 + 256 + 1024) break;
        if (q < 64) gdn_scan_chain<64>(p, lds, false, q >> 4, q & 15);
        else if (q < 320) { const int s = q - 64; gdn_scan_chain<16>(p, lds, true, s >> 4, s & 15); }
        else { const int k = q - 320, c = 31 - (k >> 5), bh = k & 31; diffattn_prompt_item(p, lds, bh >> 3, bh & 7, c, lam); }
    }
}
DEV void phase_fn4(const P* pp, LAS unsigned char* lds) {
    const P& p = *pp; unsigned char* ws = p.ws; const int bid = get_bid(), G = gridDim.x; (void)ws; (void)bid; (void)G;
#ifndef P4M
#define P4M 3
#endif
        { EpiMergeA ea; ea.ws = ws; run_gemm_split(lds, (const bf16_t*)(ws + W_OA), (const bf16_t*)(ws + W_WPA), DM, DM, 1024, ea, nullptr, 0); }
        { EpiMergeB eb; eb.ws = ws; run_gemm_split(lds, (const bf16_t*)(ws + W_OB), (const bf16_t*)(ws + W_WPB), DM, DM, 1024, eb, nullptr, 16); }
}
DEV void phase_fn5(const P* pp, LAS unsigned char* lds) {
    const P& p = *pp; unsigned char* ws = p.ws; const int bid = get_bid(), G = gridDim.x; (void)ws; (void)bid; (void)G;
        EpiResidSplit e; e.PRE = (float*)(ws + W_PRE); e.r0 = p.in[0]; e.rb = nullptr; e.PS = (float*)(ws + W_PS); e.klen = 256;
        bf16_t* scr = (bf16_t*)(ws + W_SCR) + (size_t)bid * MS * DM;
        if (bid < 64) {
            const float* MF = (const float*)(ws + W_PSM); const int kb = (bid >> 3) * 256, tid = get_tid();
            for (int i = tid; i < 256 * 64; i += 512) { const int row = i >> 6, c4 = (i & 63) * 4; const size_t o = (size_t)row * DM + kb + c4;
                const f32x4 v = *(const f32x4*)(MF + o) + *(const f32x4*)(MF + (size_t)MS * DM + o) + *(const f32x4*)(MF + (size_t)2 * MS * DM + o) + *(const f32x4*)(MF + (size_t)3 * MS * DM + o);
                *(u32x2*)(scr + o) = pk4(v); }
            __threadfence(); __syncthreads();
        }
        run_gemm_split(lds, (const bf16_t*)(ws + W_MIX), (const bf16_t*)(ws + W_WO), DM, DM, 256, e, scr, 0);
}
DEV void phase_fn6(const P* pp, LAS unsigned char* lds) {
    const P& p = *pp; unsigned char* ws = p.ws; const int bid = get_bid(), G = gridDim.x; (void)ws; (void)bid; (void)G;
        ln_phase((const float*)(ws + W_PRE), p.in[22], p.in[23], (bf16_t*)(ws + W_H1B), nullptr, p.in[1], nullptr, (const float*)(ws + W_PS), 8);
}
DEV void phase_fn7(const P* pp, LAS unsigned char* lds) {
    const P& p = *pp; unsigned char* ws = p.ws; const int bid = get_bid(), G = gridDim.x; (void)ws; (void)bid; (void)G;
        EpiPart e; e.PS = (float*)(ws + W_QXP); e.ld = XW; e.klen = 512; e.stride = (size_t)MT * XW;
        pg8::Gemm g; g.A = (const bf16_t*)(ws + W_H1B); g.Bt = (const bf16_t*)(ws + W_WXQ); g.M = MT; g.N = XW; g.K = DM; g.A2 = nullptr;
        pg8::PieceOrder S; S.nM = MT / 256; S.nN = XW / 256; S.G = G; S.c = bid; S.klen = 512; S.nsplit = 4;
        pg8::gemm_phase(lds, g, S, e);
}
DEV void phase_fn8(const P* pp, LAS unsigned char* lds) {
    const P& p = *pp; unsigned char* ws = p.ws; const int bid = get_bid(), G = gridDim.x; (void)ws; (void)bid; (void)G;
        for (int i = bid; i < 320; i += G) {
            if (i < 256) xattn_prompt_item(p, lds, i >> 6, (i >> 4) & 3, i & 15);
            else { const int s = i - 256; xattn_sample_item(p, lds, s >> 2, s & 3); }
        }
}
DEV void phase_fn9(const P* pp, LAS unsigned char* lds) {
    const P& p = *pp; unsigned char* ws = p.ws; const int bid = get_bid(), G = gridDim.x; (void)ws; (void)bid; (void)G;
        EpiResidSplit e; e.PRE = (float*)(ws + W_PRE); e.r0 = nullptr; e.rb = (const bf16_t*)(ws + W_H1B); e.PS = (float*)(ws + W_PS); e.klen = 256;
        run_gemm_split(lds, (const bf16_t*)(ws + W_OX), (const bf16_t*)(ws + W_WXO), DM, XW, 256, e);
}
DEV void phase_fn10(const P* pp, LAS unsigned char* lds) {
    const P& p = *pp; unsigned char* ws = p.ws; const int bid = get_bid(), G = gridDim.x; (void)ws; (void)bid; (void)G;
        ln_phase((const float*)(ws + W_PRE), p.in[28], p.in[29], (bf16_t*)(ws + W_H2B), nullptr, nullptr, (const bf16_t*)(ws + W_H1B) + (size_t)MP * DM, (const float*)(ws + W_PS), 2);
}
DEV void phase_fn11(const P* pp, LAS unsigned char* lds) {
    const P& p = *pp; unsigned char* ws = p.ws; const int bid = get_bid(), G = gridDim.x; (void)ws; (void)bid; (void)G;
        EpiSwiglu e; e.F = (bf16_t*)(ws + W_F);
        run_gemm(lds, (const bf16_t*)(ws + W_H2B), (const bf16_t*)(ws + W_WFF13), MT, 2 * DFF, DM, e, bid);
}
DEV void phase_fn12(const P* pp, LAS unsigned char* lds) {
    const P& p = *pp; unsigned char* ws = p.ws; const int bid = get_bid(), G = gridDim.x; (void)ws; (void)bid; (void)G;
        EpiResidSplit e; e.PRE = (float*)(ws + W_PRE); e.r0 = nullptr; e.rb = (const bf16_t*)(ws + W_H2B); e.PS = (float*)(ws + W_PS); e.klen = 512;
        run_gemm_split(lds, (const bf16_t*)(ws + W_F), (const bf16_t*)(ws + W_WFF2), DM, DFF, 512, e);
}
DEV void phase_fn13(const P* pp, LAS unsigned char* lds) {
    const P& p = *pp; unsigned char* ws = p.ws; const int bid = get_bid(), G = gridDim.x; (void)ws; (void)bid; (void)G;
        ln_phase((const float*)(ws + W_PRE), p.in[33], p.in[34], nullptr, p.out + O_YP, nullptr, (const bf16_t*)(ws + W_H2B) + (size_t)MP * DM, (const float*)(ws + W_PS), 11);
}

__global__ void __launch_bounds__(512) mega(P p) {
    extern __shared__ __attribute__((aligned(16))) unsigned char lds_raw[];
    LAS unsigned char* lds = (LAS unsigned char*)lds_raw;
    cg::grid_group grid = cg::this_grid();
    const P* pp = &p;
    const int lo = p.ph_lo, hi = p.ph_hi, dupm = p.dup;
    if (threadIdx.x < 4) ((volatile LAS unsigned*)(lds + LDS_BYTES - 32))[threadIdx.x] = 0u;
    __syncthreads();
    const XcdBarrier xb = xcd_barrier_post((unsigned*)(p.ws + W_XBAR), (volatile LAS unsigned*)(lds + LDS_BYTES - 32));
    if (hi - lo > 1) grid.sync();
#ifndef DUP_MASK
#define DUP_MASK 0
#endif
#define RUN_PH(k) if (PH_ON(k) && lo <= k && k < hi) { const int nrep = 1 + ((dupm >> k) & 1); for (int r = 0; r < nrep; ++r) { if (r) xcd_barrier(xb); phase_fn##k(pp, lds); } } if (lo <= k && k + 1 < hi) xcd_barrier(xb);
    RUN_PH(0) RUN_PH(1) RUN_PH(2) RUN_PH(3) RUN_PH(4) RUN_PH(5) RUN_PH(6) RUN_PH(7) RUN_PH(8) RUN_PH(9) RUN_PH(10) RUN_PH(11) RUN_PH(12) RUN_PH(13)
}

extern "C" void kernel_launch(void* const* d_in, const int* in_sizes, int n_in, void* d_out, int out_size, void* d_ws, size_t ws_size, hipStream_t stream) {
    static int grid_blocks = 0;
    if (!grid_blocks) {
        if (n_in != 35 || ws_size < W_END) { fprintf(stderr, "kernel_launch: unexpected n_in %d or workspace %zu < %zu\n", n_in, ws_size, (size_t)W_END); grid_blocks = -1; return; }
        int dev = 0, cus = 0, per_cu = 0;
        hipGetDevice(&dev);
        hipDeviceGetAttribute(&cus, hipDeviceAttributeMultiprocessorCount, dev);
        if (hipFuncSetAttribute((const void*)mega, hipFuncAttributeMaxDynamicSharedMemorySize, LDS_BYTES) != hipSuccess) { fprintf(stderr, "kernel_launch: hipFuncSetAttribute failed\n"); grid_blocks = -1; return; }
        hipOccupancyMaxActiveBlocksPerMultiprocessor(&per_cu, (const void*)mega, 512, LDS_BYTES);
        if (per_cu < 1) { fprintf(stderr, "kernel_launch: occupancy query says %d blocks per CU\n", per_cu); per_cu = 1; }
        if (cus != 256) { fprintf(stderr, "kernel_launch: built for a 256-CU device (got %d)\n", cus); grid_blocks = -1; return; }
        grid_blocks = cus * 1;
        (void)hipGetLastError();
    }
    if (grid_blocks < 0) return;
    (void)hipMemsetAsync((unsigned char*)d_ws + W_MISC + 128, 0, 128 + 13824, stream);
    P p{};
    for (int i = 0; i < 35; ++i) p.in[i] = (const float*)d_in[i];
    p.out = (float*)d_out; p.ws = (unsigned char*)d_ws;
#if MK_PER_PHASE
#ifndef NPH_RUN
#define NPH_RUN NPHASE
#endif
    for (int ph = 0; ph < NPH_RUN; ++ph) { p.ph_lo = ph; p.ph_hi = ph + 1; hipLaunchKernelGGL(mega, dim3(grid_blocks), dim3(512), LDS_BYTES, stream, p); }
#else
    p.ph_lo = 0; p.ph_hi = NPHASE; p.dup = DUP_MASK;
    void* args[] = {&p};
    hipError_t e = hipLaunchCooperativeKernel((const void*)mega, dim3(grid_blocks), dim3(512), args, LDS_BYTES, stream);
    if (e != hipSuccess) fprintf(stderr, "cooperative launch failed: %s (grid %d)\n", hipGetErrorString(e), grid_blocks);
#endif
}
```

```cpp
#include <hip/hip_runtime.h>
#include <hip/hip_cooperative_groups.h>
#include <cstdio>
namespace cg = cooperative_groups;

#define LAS __attribute__((address_space(3)))
#define DEV __device__ __forceinline__
typedef unsigned short bf16_t;
typedef short bf16x8 __attribute__((ext_vector_type(8)));
typedef float f32x4 __attribute__((ext_vector_type(4)));
typedef unsigned u32x4 __attribute__((ext_vector_type(4)));
typedef unsigned u32x2 __attribute__((ext_vector_type(2)));

constexpr int DM = 2048, SEQ = 2048, NB = 4, MP = NB * SEQ, SB = 16, ST = 16, MS = SB * ST, MT = MP + MS;
constexpr int PAST = 1024, NMEM = 256, DFF = 5632, XW = 512;
constexpr int NPROJ = 18688;
constexpr float ALPHA = 1.189207115002721f;
constexpr float LAM_INIT = 0.2f;
constexpr float LOG2E = 1.4426950408889634f;

constexpr size_t O_YP = 0, O_DKP = 17301504, O_DVP = 34078720, O_GSP = 50855936, O_GCP = 51904512, O_MKP = 51978240,
                 O_MVP = 52502528, O_DKS = 53026816, O_DVS = 53551104, O_GSS = 54075392, O_GCS = 58269696;

constexpr size_t SZ_ACT = (size_t)MT * DM * 2;
constexpr size_t W_WIN = 0;
constexpr size_t W_OA = W_WIN, W_OB = W_WIN + SZ_ACT;
constexpr size_t W_WXKV = W_WIN + (size_t)NPROJ * DM * 2;
constexpr size_t W_WPA = W_WXKV + (size_t)1024 * DM * 2;
constexpr size_t W_WPB = W_WPA + (size_t)DM * DM * 2;
constexpr size_t W_WO = W_WPB + (size_t)DM * DM * 2;
constexpr size_t W_WXQ = W_WO + (size_t)DM * DM * 2;
constexpr size_t W_WXO = W_WXQ + (size_t)XW * DM * 2;
constexpr size_t W_WFF13 = W_WXO + (size_t)DM * XW * 2;
constexpr size_t W_WFF2 = W_WFF13 + (size_t)2 * DFF * DM * 2;
constexpr size_t W_XB = W_WFF2 + (size_t)DM * DFF * 2;
constexpr size_t W_PRE = W_XB;
constexpr size_t W_MEMB = W_XB + SZ_ACT;
constexpr size_t W_VT = W_MEMB + (size_t)1024 * DM * 2;
constexpr size_t W_QB = W_VT + (size_t)8192 * SEQ * 2;
constexpr size_t W_H1F = W_QB;
constexpr size_t W_KB = W_QB + SZ_ACT;
constexpr size_t W_GB = W_KB + SZ_ACT;
constexpr size_t W_F = W_GB;
constexpr size_t W_ZB = W_GB + (size_t)MT * 6144 * 2;
constexpr size_t W_GATE = W_ZB + SZ_ACT;
constexpr size_t W_H2F = W_GATE;
constexpr size_t W_GAB = W_GATE + (size_t)MT * 4096 * 2;
constexpr size_t W_MEMK = W_GAB + (size_t)MT * 32 * 4;
constexpr size_t W_MEMVT = W_MEMK + (size_t)1024 * 512 * 2;
constexpr size_t W_GDN = W_MEMVT + (size_t)1024 * 512 * 2;
constexpr size_t GP_W = 0, GP_UT = 16384, GP_QG = 32768, GP_QK = 49152, GP_KDT = 57344, GP_SZ = 73728;
constexpr size_t GS_W = 0, GS_UT = 4096, GS_QG = 8192, GS_QK = 12288, GS_KDT = 13312, GS_SZ = 21504;
constexpr size_t W_GDNS = W_GDN + (size_t)2048 * GP_SZ;
constexpr size_t W_DEC = W_GDNS + (size_t)256 * GS_SZ;
constexpr size_t W_MISC = W_DEC + 16384;
constexpr size_t W_XBAR = W_MISC + 256;
constexpr size_t W_PS = W_XBAR + 13824;
constexpr size_t W_END = W_PS + (size_t)12 * MS * DM * 4;
constexpr size_t W_PSM = W_PS + (size_t)8 * MS * DM * 4;
constexpr size_t W_QXP = W_GB;
constexpr size_t W_SCR = W_GB;
constexpr size_t W_MIX = W_GDN, W_H1B = W_MIX + SZ_ACT, W_H2B = W_H1B + SZ_ACT, W_QX = W_H2B + SZ_ACT, W_OX = W_QX + (size_t)MT * XW * 2;
static_assert(W_OX + (size_t)MT * XW * 2 <= W_GDNS, "overlay");
static_assert(W_PRE + (size_t)MT * DM * 4 <= W_QB, "overlay pre");

constexpr int LDS_BYTES = 144 * 1024;

struct P { const float* in[35]; float* out; unsigned char* ws; int ph_lo, ph_hi, dup, pad; };

DEV int get_tid() { int t = threadIdx.x; asm volatile("" : "+v"(t)); return t; }
DEV int get_bid() { int t = blockIdx.x; asm volatile("" : "+s"(t)); return t; }
typedef __bf16 bf16x2_t __attribute__((ext_vector_type(2)));
typedef float f32x2_t __attribute__((ext_vector_type(2)));
DEV unsigned pk_bf16(float lo, float hi) { const f32x2_t v = {lo, hi}; return __builtin_bit_cast(unsigned, __builtin_convertvector(v, bf16x2_t)); }
DEV float bf2f(unsigned h) { return __uint_as_float(h << 16); }
DEV float bflo(unsigned w) { return __uint_as_float(w << 16); }
DEV float bfhi(unsigned w) { return __uint_as_float(w & 0xffff0000u); }
DEV float sigmoidf_(float x) { return 1.0f / (1.0f + __expf(-x)); }
DEV float siluf_(float x) { return x * sigmoidf_(x); }
DEV float ex2(float x) { return __builtin_amdgcn_exp2f(x); }
DEV u32x2 pk4(f32x4 v) { u32x2 r; r.x = pk_bf16(v[0], v[1]); r.y = pk_bf16(v[2], v[3]); return r; }

namespace pg8 {
constexpr int BM = 256, BK = 64, HALF = 128, HTB = HALF * BK * 2, STAGE_BYTES = 8 * HTB, NXCD = 8, WGM = 8;
DEV int lds_byte(int r, int c) { const int st = (r >> 4) * 2 + (c >> 5), rr = r & 15, cc = c & 31, ob = rr * 64 + cc * 2; return st * 1024 + (ob ^ (((ob >> 9) & 1) << 5)); }
DEV void stage_rc(int b, int& R, int& C) { const int st = b / 1024, sb = b % 1024, swz = sb ^ (((sb >> 9) & 1) << 5); R = (st >> 1) * 16 + swz / 64; C = (st & 1) * 32 + (swz % 64) / 2; }
struct Unit { int pm, pn, kbeg, klen; };
struct Gemm { const bf16_t* A; const bf16_t* Bt; int M, N, K; const bf16_t* A2; };
struct StaticOrder {
    int nM, nN, nwg, G, c, K;
    DEV void init(int M, int N, int G_, int c_, int K_) { nM = M / BM; nN = N / BM; nwg = nM * nN; G = G_; c = c_; K = K_; }
    DEV bool next(int i, Unit& u) const {
        const long L = (long)i * G + c; if (L >= nwg) return false;
        u.kbeg = 0; u.klen = K;
        int wgid = (int)L; { const int q = nwg / NXCD, r = nwg % NXCD, xcd = wgid % NXCD, off = wgid / NXCD; wgid = (xcd < r ? xcd * (q + 1) : r * (q + 1) + (xcd - r) * q) + off; }
        const int nig = WGM * nN, gid = wgid / nig, fm = gid * WGM, gsz = (nM - fm) < WGM ? (nM - fm) : WGM;
        u.pm = fm + ((wgid % nig) % gsz); u.pn = (wgid % nig) / gsz; return true;
    }
};
struct SplitOrder {
    int nN, G, c, K, klen, nsplit, coff;
    DEV bool next(int i, Unit& u) const {
        const int nwg = 32 * nN; const long L = (long)i * G + ((i == 0) ? c : (c - coff + G) % G);
        if (L < nwg) { int wgid = (int)L; { const int q = nwg / NXCD, r = nwg % NXCD, xcd = wgid % NXCD, off = wgid / NXCD; wgid = (xcd < r ? xcd * (q + 1) : r * (q + 1) + (xcd - r) * q) + off; }
            const int nig = WGM * nN, gid = wgid / nig, fm = gid * WGM, gsz = (32 - fm) < WGM ? (32 - fm) : WGM;
            u.pm = fm + ((wgid % nig) % gsz); u.pn = (wgid % nig) / gsz; u.kbeg = 0; u.klen = K; return true; }
        const int pc = (int)(L - nwg); if (pc >= nN * nsplit) return false;
        u.pm = 32; u.pn = pc % nN; u.kbeg = (pc / nN) * klen; u.klen = klen; return true;
    }
};
struct PieceOrder {
    int nM, nN, G, c, klen, nsplit;
    DEV bool next(int i, Unit& u) const {
        const long L = (long)i * G + c; if (L >= (long)nM * nN * nsplit) return false;
        const int t = (int)(L / nsplit), ks = (int)(L % nsplit);
        u.pm = t % nM; u.pn = t / nM; u.kbeg = ks * klen; u.klen = klen; return true;
    }
};
template <class Epi, class Sched>
DEV void gemm_phase(LAS unsigned char* lds, const Gemm g, const Sched& S, const Epi& E) {
    const int tid = get_tid(), wid = __builtin_amdgcn_readfirstlane(tid >> 6), lane = tid & 63, wr = wid >> 2, wc = wid & 3, fr = lane & 15, fq = lane >> 4;
    const int K = g.K;
    unsigned voffA[2], voffB[2];
#pragma unroll
    for (int i = 0; i < 2; ++i) { int R, C; stage_rc(tid * 16 + i * 8192, R, C); const int r5 = R & 31, Rb = (R & ~31) + 8 * ((r5 & 15) >> 2) + 4 * (r5 >> 4) + (r5 & 3);
        voffA[i] = (unsigned)(R * K + C) * 2u; voffB[i] = (unsigned)(Rb * K + C) * 2u; }
    const size_t kstep = (size_t)(BK * 2);
    const size_t hstep = (size_t)HALF * K * 2;
    const size_t tstep = 2 * hstep;
    const unsigned ldsw = (unsigned)wid * 1024u;
    const int aoff = lds_byte(wr * 64 + fr, fq * 8), boff = lds_byte(wc * 32 + fr, fq * 8);
#define PG8_SA(b, h) (((b) * 2 + (h)) * HTB)
#define PG8_SB(b, h) ((4 + (b) * 2 + (h)) * HTB)
#define PG8_STAGE(bufoff, gbase, voff) do { _Pragma("unroll") for (int _i = 0; _i < 2; ++_i) \
        __builtin_amdgcn_global_load_lds((const unsigned*)((const char*)(gbase) + (voff)[_i]), (LAS unsigned*)(lds + (bufoff) + ldsw + _i * 8192), 16, 0, 0); } while (0)
#define PG8_LDA(dst, b, h) do { _Pragma("unroll") for (int m = 0; m < 4; ++m) _Pragma("unroll") for (int k = 0; k < 2; ++k) dst[m][k] = *(const LAS bf16x8*)(lds + PG8_SA(b, h) + aoff + m * 2048 + k * 1024); } while (0)
#define PG8_LDB(dst, b, h) do { _Pragma("unroll") for (int n = 0; n < 2; ++n) _Pragma("unroll") for (int k = 0; k < 2; ++k) dst[n][k] = *(const LAS bf16x8*)(lds + PG8_SB(b, h) + boff + n * 2048 + k * 1024); } while (0)
#define PG8_MMA(ai, bj, At, Bt) do { __builtin_amdgcn_s_setprio(1); _Pragma("unroll") for (int m = 0; m < 4; ++m) _Pragma("unroll") for (int n = 0; n < 2; ++n) _Pragma("unroll") for (int k = 0; k < 2; ++k) \
        acc[ai][bj][m][n] = __builtin_amdgcn_mfma_f32_16x16x32_bf16(Bt[n][k], At[m][k], acc[ai][bj][m][n], 0, 0, 0); __builtin_amdgcn_s_setprio(0); } while (0)
#define PG8_WAIT_V(n) asm volatile("s_waitcnt vmcnt(" #n ")" ::: "memory")
#define PG8_WAIT_L(n) asm volatile("s_waitcnt lgkmcnt(" #n ")" ::: "memory")
#define PG8_BAR __builtin_amdgcn_s_barrier()
#define PG8_SCHED __builtin_amdgcn_sched_barrier(0)
    Unit cur, nxt; int ui = 0;
    if (!S.next(0, cur)) return;
    int nt = cur.klen / BK;
    f32x4 acc[2][2][4][2];
#pragma unroll
    for (int a = 0; a < 2; ++a)
#pragma unroll
        for (int b = 0; b < 2; ++b)
#pragma unroll
            for (int m = 0; m < 4; ++m)
#pragma unroll
                for (int n = 0; n < 2; ++n) acc[a][b][m][n] = (f32x4){0.f, 0.f, 0.f, 0.f};
    bf16x8 At[4][2], B0[2][2], B1[2][2];
    const char* cA = ((g.A2 && cur.pm == 32) ? (const char*)g.A2 : (const char*)g.A + (size_t)cur.pm * tstep) + (size_t)cur.kbeg * 2; const char* cB = (const char*)g.Bt + (size_t)cur.pn * tstep + (size_t)cur.kbeg * 2;
    PG8_STAGE(PG8_SB(0, 0), cB, voffB); PG8_STAGE(PG8_SA(0, 0), cA, voffA); PG8_STAGE(PG8_SB(0, 1), cB + hstep, voffB); PG8_STAGE(PG8_SA(0, 1), cA + hstep, voffA);
    if (wr == 1) PG8_BAR;
    PG8_WAIT_V(4); PG8_BAR;
    PG8_STAGE(PG8_SB(1, 0), cB + kstep, voffB); PG8_STAGE(PG8_SA(1, 0), cA + kstep, voffA); PG8_STAGE(PG8_SB(1, 1), cB + hstep + kstep, voffB);
    PG8_WAIT_V(6); PG8_BAR;
    for (;;) {
        const bool has_next = S.next(ui + 1, nxt);
        const char* nA = has_next ? ((g.A2 && nxt.pm == 32) ? (const char*)g.A2 : (const char*)g.A + (size_t)nxt.pm * tstep) + (size_t)nxt.kbeg * 2 : cA; const char* nB = has_next ? (const char*)g.Bt + (size_t)nxt.pn * tstep + (size_t)nxt.kbeg * 2 : cB;
        for (int t = 0; t < nt; t += 2) {
            const bool last = (t == nt - 2);
            const char* a1 = cA + (size_t)(t + 1) * kstep;
            const char* a2 = last ? nA : cA + (size_t)(t + 2) * kstep; const char* b2 = last ? nB : cB + (size_t)(t + 2) * kstep;
            const char* a3 = a2 + kstep; const char* b3 = b2 + kstep;
            PG8_LDB(B0, 0, 0); PG8_SCHED; PG8_LDA(At, 0, 0); PG8_STAGE(PG8_SA(1, 1), a1 + hstep, voffA);
            PG8_WAIT_L(8); PG8_BAR; PG8_WAIT_L(0); PG8_MMA(0, 0, At, B0); PG8_BAR; PG8_SCHED;
            PG8_LDB(B1, 0, 1); PG8_STAGE(PG8_SB(0, 0), b2, voffB);
            PG8_BAR; PG8_WAIT_L(0); PG8_MMA(0, 1, At, B1); PG8_BAR;
            PG8_LDA(At, 0, 1); PG8_STAGE(PG8_SA(0, 0), a2, voffA);
            PG8_BAR; PG8_WAIT_L(0); PG8_MMA(1, 0, At, B0); PG8_BAR; PG8_SCHED;
            PG8_STAGE(PG8_SB(0, 1), b2 + hstep, voffB);
            PG8_WAIT_V(6); PG8_BAR; PG8_MMA(1, 1, At, B1); PG8_BAR;
            PG8_LDB(B0, 1, 0); PG8_SCHED; PG8_LDA(At, 1, 0); PG8_STAGE(PG8_SA(0, 1), a2 + hstep, voffA);
            PG8_WAIT_L(8); PG8_BAR; PG8_WAIT_L(0); PG8_MMA(0, 0, At, B0); PG8_BAR; PG8_SCHED;
            PG8_LDB(B1, 1, 1); PG8_STAGE(PG8_SB(1, 0), b3, voffB);
            PG8_BAR; PG8_WAIT_L(0); PG8_MMA(0, 1, At, B1); PG8_BAR;
            PG8_LDA(At, 1, 1); PG8_STAGE(PG8_SA(1, 0), a3, voffA);
            PG8_BAR; PG8_WAIT_L(0); PG8_MMA(1, 0, At, B0); PG8_BAR; PG8_SCHED;
            PG8_STAGE(PG8_SB(1, 1), b3 + hstep, voffB);
            PG8_WAIT_V(6); PG8_BAR; PG8_MMA(1, 1, At, B1); PG8_BAR;
        }
        E(acc, cur, wr, wc, fr, fq);
        if (!has_next) break;
#pragma unroll
        for (int a = 0; a < 2; ++a)
#pragma unroll
            for (int b = 0; b < 2; ++b)
#pragma unroll
                for (int m = 0; m < 4; ++m)
#pragma unroll
                    for (int n = 0; n < 2; ++n) acc[a][b][m][n] = (f32x4){0.f, 0.f, 0.f, 0.f};
        cur = nxt; cA = nA; cB = nB; ++ui; nt = cur.klen / BK;
    }
    PG8_WAIT_V(0);
    if (wr == 0) PG8_BAR;
    PG8_BAR;
#undef PG8_SA
#undef PG8_SB
#undef PG8_STAGE
#undef PG8_LDA
#undef PG8_LDB
#undef PG8_MMA
#undef PG8_WAIT_V
#undef PG8_WAIT_L
#undef PG8_BAR
#undef PG8_SCHED
}
}
using pg8::Unit;
typedef f32x4 Acc[2][2][4][2];

#define EPI_FOR(ROW0, COL0) \
    _Pragma("unroll") for (int ai = 0; ai < 2; ++ai) _Pragma("unroll") for (int m = 0; m < 4; ++m) { asm volatile("" ::: "memory"); const int row = (ROW0) + ai * 128 + m * 16; \
    _Pragma("unroll") for (int bj = 0; bj < 2; ++bj) _Pragma("unroll") for (int n = 0; n < 2; ++n) { const int col = (COL0) + bj * 128 + n * 4; const f32x4 v = acc[ai][bj][m][n];
#define EPI_END }}

struct EpiProj {
    unsigned char* ws; float* out;
    DEV void operator()(const Acc& acc, const Unit& u, int wr, int wc, int fr, int fq) const {
        const int row0 = u.pm * 256 + wr * 64 + fr, col0 = u.pn * 256 + wc * 32 + 8 * fq;
        const int reg = u.pn >> 3;
        if (u.pn == 72) {
            if (wc == 0) { float* gab = (float*)(ws + W_GAB);
#pragma unroll
                for (int ai = 0; ai < 2; ++ai)
#pragma unroll
                    for (int m = 0; m < 4; ++m)
#pragma unroll
                        for (int n = 0; n < 2; ++n) { const int row = row0 + ai * 128 + m * 16; *(f32x4*)(gab + (size_t)row * 32 + n * 4 + 8 * fq) = acc[ai][0][m][n]; } }
            return;
        }
        if (reg == 0) { bf16_t* Q = (bf16_t*)(ws + W_QB);
            EPI_FOR(row0, col0) *(u32x2*)(Q + (size_t)row * DM + col) = pk4(v); EPI_END
        } else if (reg == 1) { bf16_t* Kb = (bf16_t*)(ws + W_KB);
            EPI_FOR(row0, col0 - 2048) *(u32x2*)(Kb + (size_t)row * DM + col) = pk4(v);
                float* o = row < MP ? out + O_DKP + (size_t)row * DM : out + O_DKS + (size_t)(row - MP) * DM;
                if (u.pm < 32) __builtin_nontemporal_store(v, (f32x4*)(o + col)); else *(f32x4*)(o + col) = v; EPI_END
        } else if (reg == 2) { bf16_t* VT = (bf16_t*)(ws + W_VT);
            EPI_FOR(row0, col0 - 4096)
                float* o = row < MP ? out + O_DVP + (size_t)row * DM : out + O_DVS + (size_t)(row - MP) * DM;
                if (u.pm < 32) __builtin_nontemporal_store(v, (f32x4*)(o + col)); else *(f32x4*)(o + col) = v;
                if (row < MP) { const int b = row >> 11, t = row & 2047; bf16_t* d = VT + ((size_t)(b * 2048 + col)) * SEQ + t;
                    const u32x2 pk = pk4(v); d[0] = (bf16_t)(pk.x & 0xffff); d[SEQ] = (bf16_t)(pk.x >> 16); d[2 * SEQ] = (bf16_t)(pk.y & 0xffff); d[3 * SEQ] = (bf16_t)(pk.y >> 16); }
            EPI_END
        } else if (reg <= 5) { bf16_t* G = (bf16_t*)(ws + W_GB);
            EPI_FOR(row0, col0 - 6144) *(u32x2*)(G + (size_t)row * 6144 + col) = pk4(v);
                if (row < MP) { const int t = row & 2047; if (t >= 2045) *(f32x4*)(out + O_GCP + ((size_t)(row >> 11) * 3 + (t - 2045)) * 6144 + col) = v; }
                else { const int t = (row - MP) & 15; if (t >= 13) *(f32x4*)(out + O_GCS + ((size_t)((row - MP) >> 4) * 3 + (t - 13)) * 6144 + col) = v; }
            EPI_END
        } else if (reg == 6) { bf16_t* Z = (bf16_t*)(ws + W_ZB);
            EPI_FOR(row0, col0 - 12288) *(u32x2*)(Z + (size_t)row * DM + col) = pk4(v); EPI_END
        } else { bf16_t* GT = (bf16_t*)(ws + W_GATE);
            EPI_FOR(row0, col0 - 14336) f32x4 s; s[0] = sigmoidf_(v[0]); s[1] = sigmoidf_(v[1]); s[2] = sigmoidf_(v[2]); s[3] = sigmoidf_(v[3]);
                *(u32x2*)(GT + (size_t)row * 4096 + col) = pk4(s); EPI_END
        }
    }
};
struct EpiMemKV {
    unsigned char* ws; float* out;
    DEV void operator()(const Acc& acc, const Unit& u, int wr, int wc, int fr, int fq) const {
        const int row0 = u.pm * 256 + wr * 64 + fr, col0 = u.pn * 256 + wc * 32 + 8 * fq;
        if (u.pn < 2) { bf16_t* MK = (bf16_t*)(ws + W_MEMK);
            EPI_FOR(row0, col0) *(u32x2*)(MK + (size_t)row * 512 + col) = pk4(v); *(f32x4*)(out + O_MKP + (size_t)row * 512 + col) = v; EPI_END
        } else { bf16_t* MVT = (bf16_t*)(ws + W_MEMVT);
            EPI_FOR(row0, col0 - 512) *(f32x4*)(out + O_MVP + (size_t)row * 512 + col) = v;
                const int b = row >> 8, mm = row & 255; bf16_t* d = MVT + ((size_t)(b * 512 + col)) * 256 + mm; const u32x2 pk = pk4(v);
                d[0] = (bf16_t)(pk.x & 0xffff); d[256] = (bf16_t)(pk.x >> 16); d[512] = (bf16_t)(pk.y & 0xffff); d[768] = (bf16_t)(pk.y >> 16); EPI_END
        }
    }
};
struct EpiMergeA {
    unsigned char* ws;
    DEV void operator()(const Acc& acc, const Unit& u, int wr, int wc, int fr, int fq) const {
        const int row0 = u.pm * 256 + wr * 64 + fr, col0 = u.pn * 256 + wc * 32 + 8 * fq;
        const bf16_t* GT = (const bf16_t*)(ws + W_GATE); float* PRE = (float*)(ws + W_PRE);
        if (u.pm == 32) { float* MF = (float*)(ws + W_PSM) + (size_t)(u.kbeg >> 10) * MS * DM;
            EPI_FOR(row0, col0) const u32x2 gt = *(const u32x2*)(GT + (size_t)row * 4096 + col);
                f32x4 r; r[0] = v[0] * bflo(gt.x); r[1] = v[1] * bfhi(gt.x); r[2] = v[2] * bflo(gt.y); r[3] = v[3] * bfhi(gt.y); *(f32x4*)(MF + (size_t)(row - MP) * DM + col) = r; EPI_END
            return; }
        EPI_FOR(row0, col0) const u32x2 gt = *(const u32x2*)(GT + (size_t)row * 4096 + col);
            f32x4 r; r[0] = v[0] * bflo(gt.x); r[1] = v[1] * bfhi(gt.x); r[2] = v[2] * bflo(gt.y); r[3] = v[3] * bfhi(gt.y);
            *(f32x4*)(PRE + (size_t)row * DM + col) = r; EPI_END
    }
};
struct EpiMergeB {
    unsigned char* ws;
    DEV void operator()(const Acc& acc, const Unit& u, int wr, int wc, int fr, int fq) const {
        const int row0 = u.pm * 256 + wr * 64 + fr, col0 = u.pn * 256 + wc * 32 + 8 * fq;
        const bf16_t* GT = (const bf16_t*)(ws + W_GATE); const float* PRE = (const float*)(ws + W_PRE); bf16_t* MIX = (bf16_t*)(ws + W_MIX);
        if (u.pm == 32) { float* MF = (float*)(ws + W_PSM) + (size_t)(2 + (u.kbeg >> 10)) * MS * DM;
            EPI_FOR(row0, col0) const u32x2 gt = *(const u32x2*)(GT + (size_t)row * 4096 + 2048 + col);
                f32x4 r; r[0] = v[0] * bflo(gt.x); r[1] = v[1] * bfhi(gt.x); r[2] = v[2] * bflo(gt.y); r[3] = v[3] * bfhi(gt.y); *(f32x4*)(MF + (size_t)(row - MP) * DM + col) = r; EPI_END
            return; }
        EPI_FOR(row0, col0) const u32x2 gt = *(const u32x2*)(GT + (size_t)row * 4096 + 2048 + col); const f32x4 pa = *(const f32x4*)(PRE + (size_t)row * DM + col);
            f32x4 r; r[0] = pa[0] + v[0] * bflo(gt.x); r[1] = pa[1] + v[1] * bfhi(gt.x); r[2] = pa[2] + v[2] * bflo(gt.y); r[3] = pa[3] + v[3] * bfhi(gt.y);
            *(u32x2*)(MIX + (size_t)row * DM + col) = pk4(r); EPI_END
    }
};
struct EpiResid {
    float* PRE; const float* r0; const float* r1;
    DEV void operator()(const Acc& acc, const Unit& u, int wr, int wc, int fr, int fq) const {
        const int row0 = u.pm * 256 + wr * 64 + fr, col0 = u.pn * 256 + wc * 32 + 8 * fq;
        EPI_FOR(row0, col0) const float* rp = row < MP ? r0 + (size_t)row * DM : r1 + (size_t)(row - MP) * DM; const f32x4 x = *(const f32x4*)(rp + col);
            *(f32x4*)(PRE + (size_t)row * DM + col) = x * ALPHA + v; EPI_END
    }
};
struct EpiBf {
    bf16_t* O; int ld;
    DEV void operator()(const Acc& acc, const Unit& u, int wr, int wc, int fr, int fq) const {
        const int row0 = u.pm * 256 + wr * 64 + fr, col0 = u.pn * 256 + wc * 32 + 8 * fq;
        EPI_FOR(row0, col0) *(u32x2*)(O + (size_t)row * ld + col) = pk4(v); EPI_END
    }
};
struct EpiPart {
    float* PS; int ld, klen; size_t stride;
    DEV void operator()(const Acc& acc, const Unit& u, int wr, int wc, int fr, int fq) const {
        const int row0 = u.pm * 256 + wr * 64 + fr, col0 = u.pn * 256 + wc * 32 + 8 * fq;
        float* ps = PS + (size_t)(u.kbeg / klen) * stride;
        EPI_FOR(row0, col0) *(f32x4*)(ps + (size_t)row * ld + col) = v; EPI_END
    }
};
struct EpiSwiglu {
    bf16_t* F;
    DEV void operator()(const Acc& acc, const Unit& u, int wr, int wc, int fr, int fq) const {
        const int row0 = u.pm * 256 + wr * 64 + fr, col0 = u.pn * 128 + wc * 32 + 8 * fq;
#pragma unroll
        for (int ai = 0; ai < 2; ++ai)
#pragma unroll
            for (int m = 0; m < 4; ++m)
#pragma unroll
                for (int n = 0; n < 2; ++n) { const int row = row0 + ai * 128 + m * 16, col = col0 + n * 4; const f32x4 a = acc[ai][0][m][n], b = acc[ai][1][m][n];
                    f32x4 r; r[0] = siluf_(a[0]) * b[0]; r[1] = siluf_(a[1]) * b[1]; r[2] = siluf_(a[2]) * b[2]; r[3] = siluf_(a[3]) * b[3];
                    *(u32x2*)(F + (size_t)row * DFF + col) = pk4(r); }
    }
};

struct EpiResidSplit {
    float* PRE; const float* r0; const bf16_t* rb; float* PS; int klen;
    DEV void operator()(const Acc& acc, const Unit& u, int wr, int wc, int fr, int fq) const {
        const int row0 = u.pm * 256 + wr * 64 + fr, col0 = u.pn * 256 + wc * 32 + 8 * fq;
        if (u.pm < 32) {
            if (r0) { EPI_FOR(row0, col0) const f32x4 x = *(const f32x4*)(r0 + (size_t)row * DM + col); *(f32x4*)(PRE + (size_t)row * DM + col) = x * ALPHA + v; EPI_END }
            else { EPI_FOR(row0, col0) const u32x2 xb = *(const u32x2*)(rb + (size_t)row * DM + col); f32x4 x; x[0] = bflo(xb.x); x[1] = bfhi(xb.x); x[2] = bflo(xb.y); x[3] = bfhi(xb.y);
                *(f32x4*)(PRE + (size_t)row * DM + col) = x * ALPHA + v; EPI_END }
        } else { float* ps = PS + (size_t)(u.kbeg / klen) * MS * DM;
            EPI_FOR(row0 - MP, col0) *(f32x4*)(ps + (size_t)row * DM + col) = v; EPI_END
        }
    }
};
template <class Epi>
DEV void run_gemm_split(LAS unsigned char* lds, const bf16_t* A, const bf16_t* Bt, int N, int K, int klen, const Epi& E, const bf16_t* A2 = nullptr, int coff = 0) {
    pg8::Gemm g; g.A = A; g.Bt = Bt; g.M = MT; g.N = N; g.K = K; g.A2 = A2;
    pg8::SplitOrder S; S.nN = N / 256; S.G = (int)gridDim.x; S.c = get_bid(); S.K = K; S.klen = klen; S.nsplit = K / klen; S.coff = coff;
    pg8::gemm_phase(lds, g, S, E);
}
template <class Epi>
DEV void run_gemm(LAS unsigned char* lds, const bf16_t* A, const bf16_t* Bt, int M, int N, int K, const Epi& E, int c) {
    pg8::Gemm g; g.A = A; g.Bt = Bt; g.M = M; g.N = N; g.K = K; g.A2 = nullptr;
    pg8::StaticOrder S; S.init(M, N, (int)gridDim.x, c, K);
    pg8::gemm_phase(lds, g, S, E);
}

DEV void conv_tile(const float* __restrict__ src, int ld, int k0, int n0, int nvalid, bf16_t* __restrict__ dst, int K, int drow0, int mode, LAS float* tile) {
    const int tid = get_tid();
    {
        const int n = (tid & 63) * 4, kk = tid >> 6;
#pragma unroll
        for (int i = 0; i < 8; ++i) { const int k = kk + 8 * i;
            f32x4 v = (f32x4){0.f, 0.f, 0.f, 0.f};
            if (n < nvalid) v = *(const f32x4*)(src + (size_t)(k0 + k) * ld + n0 + n);
            LAS float* t = tile + k * 257 + n; t[0] = v[0]; t[1] = v[1]; t[2] = v[2]; t[3] = v[3]; }
    }
    __syncthreads();
#pragma unroll
    for (int i = 0; i < 4; ++i) { const int idx = tid + 512 * i, seg = idx & 7, n = idx >> 3;
        const LAS float* t = tile + (seg * 8) * 257 + n;
        u32x4 o; o.x = pk_bf16(t[0], t[257]); o.y = pk_bf16(t[2 * 257], t[3 * 257]); o.z = pk_bf16(t[4 * 257], t[5 * 257]); o.w = pk_bf16(t[6 * 257], t[7 * 257]);
        int drow;
        if (mode == 0) drow = drow0 + n; else { const int nn = n0 + n; drow = (nn >> 7) * 256 + (nn & 127) + (mode - 1) * 128; }
        *(u32x4*)(dst + (size_t)drow * K + k0 + seg * 8) = o; }
    __syncthreads();
}
DEV void cvt_rows(const float* __restrict__ src, bf16_t* __restrict__ dst, size_t n, size_t gtid, size_t gsz) {
    for (size_t i = gtid * 8; i < n; i += gsz * 8) { const f32x4 a = *(const f32x4*)(src + i), b = *(const f32x4*)(src + i + 4);
        u32x4 o; o.x = pk_bf16(a[0], a[1]); o.y = pk_bf16(a[2], a[3]); o.z = pk_bf16(b[0], b[1]); o.w = pk_bf16(b[2], b[3]); *(u32x4*)(dst + i) = o; }
}
DEV void conv_job(const P& p, int t, LAS float* tile) {
    unsigned char* ws = p.ws;
    const float* src; int ld, K, nc0, nvalid = 256, drow0, mode = 0, ntn, tt; bf16_t* dst;
    if (t < 1792)      { tt = t;    src = p.in[9];  ld = 18464; K = DM;  ntn = 56; dst = (bf16_t*)(ws + W_WIN);  nc0 = 0;     drow0 = 0; }
    else if (t < 2304) { tt = t - 1792; src = p.in[9];  ld = 18464; K = DM;  ntn = 16; dst = (bf16_t*)(ws + W_WIN);  nc0 = 14368; drow0 = 14336; }
    else if (t < 2336) { tt = t - 2304; src = p.in[9];  ld = 18464; K = DM;  ntn = 1;  dst = (bf16_t*)(ws + W_WIN);  nc0 = 14336; drow0 = 18432; nvalid = 32; }
    else if (t < 2400) { tt = t - 2336; src = p.in[25]; ld = XW;    K = DM;  ntn = 2;  dst = (bf16_t*)(ws + W_WXKV); nc0 = 0;     drow0 = 0; }
    else if (t < 2464) { tt = t - 2400; src = p.in[26]; ld = XW;    K = DM;  ntn = 2;  dst = (bf16_t*)(ws + W_WXKV); nc0 = 0;     drow0 = 512; }
    else if (t < 2720) { tt = t - 2464; src = p.in[19]; ld = DM;    K = DM;  ntn = 8;  dst = (bf16_t*)(ws + W_WPA);  nc0 = 0;     drow0 = 0; }
    else if (t < 2976) { tt = t - 2720; src = p.in[20]; ld = DM;    K = DM;  ntn = 8;  dst = (bf16_t*)(ws + W_WPB);  nc0 = 0;     drow0 = 0; }
    else if (t < 3232) { tt = t - 2976; src = p.in[21]; ld = DM;    K = DM;  ntn = 8;  dst = (bf16_t*)(ws + W_WO);   nc0 = 0;     drow0 = 0; }
    else if (t < 3296) { tt = t - 3232; src = p.in[24]; ld = XW;    K = DM;  ntn = 2;  dst = (bf16_t*)(ws + W_WXQ);  nc0 = 0;     drow0 = 0; }
    else if (t < 3360) { tt = t - 3296; src = p.in[27]; ld = DM;    K = XW;  ntn = 8;  dst = (bf16_t*)(ws + W_WXO);  nc0 = 0;     drow0 = 0; }
    else if (t < 4064) { tt = t - 3360; src = p.in[30]; ld = DFF;   K = DM;  ntn = 22; dst = (bf16_t*)(ws + W_WFF13); nc0 = 0;    drow0 = 0; mode = 1; }
    else if (t < 4768) { tt = t - 4064; src = p.in[31]; ld = DFF;   K = DM;  ntn = 22; dst = (bf16_t*)(ws + W_WFF13); nc0 = 0;    drow0 = 0; mode = 2; }
    else           { tt = t - 4768; src = p.in[32]; ld = DM;    K = DFF; ntn = 8;  dst = (bf16_t*)(ws + W_WFF2); nc0 = 0;     drow0 = 0; }
    const int tn = tt % ntn, tk = tt / ntn;
    conv_tile(src, ld, tk * 64, nc0 + tn * 256, nvalid, dst, K, drow0 + tn * 256, mode, tile);
}
constexpr int NT_CONV0 = 2464, NT_CONV = 5472;
__device__ void phase0(const P& p, LAS unsigned char* lds) {
    unsigned char* ws = p.ws;
    const size_t gtid = (size_t)get_bid() * 512 + get_tid(), gsz = (size_t)gridDim.x * 512;
    cvt_rows(p.in[0], (bf16_t*)(ws + W_XB), (size_t)MP * DM, gtid, gsz);
    cvt_rows(p.in[1], (bf16_t*)(ws + W_XB) + (size_t)MP * DM, (size_t)MS * DM, gtid, gsz);
    cvt_rows(p.in[2], (bf16_t*)(ws + W_MEMB), (size_t)1024 * DM, gtid, gsz);
    if (blockIdx.x == 0 && threadIdx.x < 64) {
        const int l = threadIdx.x; float a = p.in[11][l] * p.in[12][l] + p.in[11][l + 64] * p.in[12][l + 64], b = p.in[13][l] * p.in[14][l] + p.in[13][l + 64] * p.in[14][l + 64];
#pragma unroll
        for (int o = 32; o >= 1; o >>= 1) { a += __shfl_xor(a, o); b += __shfl_xor(b, o); }
        if (l == 0) ((float*)(ws + W_MISC))[0] = __expf(a) - __expf(b) + LAM_INIT;
    }
    for (int t = get_bid(); t < NT_CONV0; t += gridDim.x) conv_job(p, t, (LAS float*)lds);
}

DEV void ln_phase(const float* __restrict__ pre, const float* __restrict__ g, const float* __restrict__ b, bf16_t* outb, float* outf, const float* __restrict__ rs, const bf16_t* __restrict__ rsb, const float* __restrict__ ps, int nsplit) {
    const int tid_ = get_tid(), lane = tid_ & 63, gw = get_bid() * 8 + (tid_ >> 6), nw = gridDim.x * 8;
    for (int r = gw; r < MT; r += nw) {
        const float* x = pre + (size_t)r * DM;
        f32x4 v[8]; float s = 0.f;
#pragma unroll
        for (int i = 0; i < 8; ++i) {
            if (r < MP) v[i] = *(const f32x4*)(x + i * 256 + lane * 4);
            else { const size_t o = (size_t)(r - MP) * DM + i * 256 + lane * 4; f32x4 a;
                if (rs) a = *(const f32x4*)(rs + o) * ALPHA; else { const u32x2 xb = *(const u32x2*)(rsb + o); a[0] = bflo(xb.x) * ALPHA; a[1] = bfhi(xb.x) * ALPHA; a[2] = bflo(xb.y) * ALPHA; a[3] = bfhi(xb.y) * ALPHA; }
                for (int k = 0; k < nsplit; ++k) a = a + *(const f32x4*)(ps + (size_t)k * MS * DM + o);
                v[i] = a; }
            s += v[i][0] + v[i][1] + v[i][2] + v[i][3]; }
#pragma unroll
        for (int o = 32; o >= 1; o >>= 1) s += __shfl_xor(s, o);
        const float mu = s * (1.0f / DM); float q = 0.f;
#pragma unroll
        for (int i = 0; i < 8; ++i) { v[i] = v[i] - mu; q += v[i][0] * v[i][0] + v[i][1] * v[i][1] + v[i][2] * v[i][2] + v[i][3] * v[i][3]; }
#pragma unroll
        for (int o = 32; o >= 1; o >>= 1) q += __shfl_xor(q, o);
        const float rs = rsqrtf(q * (1.0f / DM) + 1e-5f);
#pragma unroll
        for (int i = 0; i < 8; ++i) { const int c = i * 256 + lane * 4; const f32x4 gg = *(const f32x4*)(g + c), bb = *(const f32x4*)(b + c);
            const f32x4 y = v[i] * rs * gg + bb;
            if (outf) __builtin_nontemporal_store(y, (f32x4*)(outf + (size_t)r * DM + c));
            if (outb) *(u32x2*)(outb + (size_t)r * DM + c) = pk4(y); }
    }
}

template <int NE, bool BIAS>
DEV void attn_step(const LAS unsigned char* Kl, int KS, const LAS unsigned char* Vl, int VS, const bf16x8 (&qf)[4], f32x4 (&o)[NE], float& m, float& l,
                   float sc2, float sl2, int qpos, int kpos0, int nvalid, int lane) {
    const int fr = lane & 15, g = lane >> 4;
    f32x4 s[4];
    {
        bf16x8 ka[2][4];
#pragma unroll
        for (int ks = 0; ks < 4; ++ks) ka[0][ks] = *(const LAS bf16x8*)(Kl + fr * KS + ks * 64 + g * 16);
#pragma unroll
        for (int kt = 0; kt < 4; ++kt) {
            if (kt < 3) {
#pragma unroll
                for (int ks = 0; ks < 4; ++ks) ka[(kt + 1) & 1][ks] = *(const LAS bf16x8*)(Kl + ((kt + 1) * 16 + fr) * KS + ks * 64 + g * 16);
            }
            __builtin_amdgcn_sched_barrier(0);
            s[kt] = (f32x4){0.f, 0.f, 0.f, 0.f};
#pragma unroll
            for (int ks = 0; ks < 4; ++ks) s[kt] = __builtin_amdgcn_mfma_f32_16x16x32_bf16(ka[kt & 1][ks], qf[ks], s[kt], 0, 0, 0);
            __builtin_amdgcn_sched_barrier(0);
        }
    }
    float mx = -INFINITY;
#pragma unroll
    for (int kt = 0; kt < 4; ++kt)
#pragma unroll
        for (int j = 0; j < 4; ++j) { const int key = kt * 16 + g * 4 + j; float v = s[kt][j] * sc2;
            if (BIAS) v -= sl2 * fabsf((float)(qpos - (kpos0 + key)));
            if (key >= nvalid) v = -INFINITY;
            s[kt][j] = v; mx = fmaxf(mx, v); }
    mx = fmaxf(mx, __shfl_xor(mx, 16)); mx = fmaxf(mx, __shfl_xor(mx, 32));
    const float mn = fmaxf(m, mx), al = ex2(m - mn); m = mn;
    float ps = 0.f;
#pragma unroll
    for (int kt = 0; kt < 4; ++kt)
#pragma unroll
        for (int j = 0; j < 4; ++j) { const float pv = ex2(s[kt][j] - mn); ps += pv; s[kt][j] = pv; }
    l = l * al + ps;
#pragma unroll
    for (int e = 0; e < NE; ++e) o[e] = o[e] * al;
    bf16x8 pb[2];
#pragma unroll
    for (int I = 0; I < 2; ++I) { u32x4 pw; pw.x = pk_bf16(s[2 * I][0], s[2 * I][1]); pw.y = pk_bf16(s[2 * I][2], s[2 * I][3]); pw.z = pk_bf16(s[2 * I + 1][0], s[2 * I + 1][1]); pw.w = pk_bf16(s[2 * I + 1][2], s[2 * I + 1][3]);
        pb[I] = __builtin_bit_cast(bf16x8, pw); }
    constexpr int NG = 2 * NE / 4;
    u32x4 vb[2][4];
#pragma unroll
    for (int q = 0; q < 4; ++q) { const int et = q % NE, I = q / NE; const LAS unsigned char* vp = Vl + (et * 16 + fr) * VS + (32 * I + 4 * g) * 2;
        const u32x2 lo = *(const LAS u32x2*)vp, hi = *(const LAS u32x2*)(vp + 32); vb[0][q] = (u32x4){lo.x, lo.y, hi.x, hi.y}; }
#pragma unroll
    for (int grp = 0; grp < NG; ++grp) {
        if (grp + 1 < NG) {
#pragma unroll
            for (int q = 0; q < 4; ++q) { const int pidx = (grp + 1) * 4 + q, et = pidx % NE, I = pidx / NE; const LAS unsigned char* vp = Vl + (et * 16 + fr) * VS + (32 * I + 4 * g) * 2;
                const u32x2 lo = *(const LAS u32x2*)vp, hi = *(const LAS u32x2*)(vp + 32); vb[(grp + 1) & 1][q] = (u32x4){lo.x, lo.y, hi.x, hi.y}; }
        }
        __builtin_amdgcn_sched_barrier(0);
#pragma unroll
        for (int q = 0; q < 4; ++q) { const int pidx = grp * 4 + q, et = pidx % NE, I = pidx / NE;
            o[et] = __builtin_amdgcn_mfma_f32_16x16x32_bf16(__builtin_bit_cast(bf16x8, vb[grp & 1][q]), pb[I], o[et], 0, 0, 0); }
        __builtin_amdgcn_sched_barrier(0);
    }
}

constexpr int DA_KS = 528, DA_VS = 144, DA_VOFF = 64 * DA_KS;
constexpr float SC2 = 0.08838834764831845f * LOG2E;

template <int NE>
DEV void diff_finalize(f32x4 (&o)[NE], float l, int sm, int slot, int e0, bool cross, float lam, const float* __restrict__ subg, bf16_t* orow, LAS unsigned char* lds, int lane) {
    const int fr = lane & 15, g = lane >> 4;
    LAS float* X = (LAS float*)lds; LAS float* SS = (LAS float*)(lds + 65536);
    l += __shfl_xor(l, 16); l += __shfl_xor(l, 32);
    const float inv = 1.0f / l;
#pragma unroll
    for (int e = 0; e < NE; ++e) o[e] = o[e] * inv;
    __syncthreads();
    if (sm == 1) {
#pragma unroll
        for (int et = 0; et < NE; ++et)
#pragma unroll
            for (int j = 0; j < 4; ++j) X[(slot * NE * 16 + et * 16 + g * 4 + j) * 16 + fr] = o[et][j];
    }
    __syncthreads();
    float ss = 0.f;
    if (sm == 0) {
#pragma unroll
        for (int et = 0; et < NE; ++et)
#pragma unroll
            for (int j = 0; j < 4; ++j) { const float v = o[et][j] - lam * X[(slot * NE * 16 + et * 16 + g * 4 + j) * 16 + fr]; o[et][j] = v; ss += v * v; }
        ss += __shfl_xor(ss, 16); ss += __shfl_xor(ss, 32);
        if (cross && g == 0) SS[slot * 16 + fr] = ss;
    }
    __syncthreads();
    if (sm == 0) {
        if (cross) ss = SS[fr] + SS[16 + fr] + SS[32 + fr] + SS[48 + fr];
        const float r = rsqrtf(ss * (1.0f / 256.0f) + 1e-6f) * (1.0f - LAM_INIT);
#pragma unroll
        for (int et = 0; et < NE; ++et) { const int e = e0 + et * 16 + g * 4; const f32x4 gg = *(const f32x4*)(subg + e);
            f32x4 y = o[et] * r * gg; *(u32x2*)(orow + e) = pk4(y); }
    }
    __syncthreads();
}

DEV void diffattn_prompt_item(const P& p, LAS unsigned char* lds, int b, int h, int c, float lam) {
    const int tid = get_tid(), wid = __builtin_amdgcn_readfirstlane(tid >> 6), lane = tid & 63, fr = lane & 15, g = lane >> 4;
    const int sm = wid & 1, rg = wid >> 1;
    unsigned char* ws = p.ws;
    const bf16_t* QB = (const bf16_t*)(ws + W_QB); const unsigned char* KBp = ws + W_KB; const unsigned char* VTp = ws + W_VT;
    const int qrow = b * SEQ + c * 64 + rg * 16 + fr;
    bf16x8 qf[4];
#pragma unroll
    for (int ks = 0; ks < 4; ++ks) qf[ks] = *(const bf16x8*)(QB + (size_t)qrow * DM + h * 256 + sm * 128 + ks * 32 + g * 8);
    f32x4 o[16];
#pragma unroll
    for (int e = 0; e < 16; ++e) o[e] = (f32x4){0.f, 0.f, 0.f, 0.f};
    float m = -INFINITY, l = 0.f;
    const float sl2 = ex2(-(float)(h + 1)) * LOG2E;
    const unsigned char* kg0 = KBp + ((size_t)(b * SEQ + (tid >> 5)) * DM + h * 256) * 2 + (tid & 31) * 16; const int kl0 = (tid >> 5) * DA_KS + (tid & 31) * 16;
    const unsigned char* vg0 = VTp + ((size_t)((b * 8 + h) * 256 + (tid >> 3)) * SEQ) * 2 + (tid & 7) * 16; const int vl0 = DA_VOFF + (tid >> 3) * DA_VS + (tid & 7) * 16;
    constexpr size_t KGS = (size_t)16 * DM * 2, VGS = (size_t)64 * SEQ * 2; constexpr int KLS = 16 * DA_KS, VLS = 64 * DA_VS;
    u32x4 kreg[4], vreg[4];
#pragma unroll
    for (int i = 0; i < 4; ++i) { kreg[i] = *(const u32x4*)(kg0 + i * KGS); vreg[i] = *(const u32x4*)(vg0 + i * VGS); }
    for (int kt = 0; kt <= c; ++kt) {
        __syncthreads();
#pragma unroll
        for (int i = 0; i < 4; ++i) { *(LAS u32x4*)(lds + kl0 + i * KLS) = kreg[i]; *(LAS u32x4*)(lds + vl0 + i * VLS) = vreg[i]; }
        __syncthreads();
        if (kt < c) {
#pragma unroll
            for (int i = 0; i < 4; ++i) { kreg[i] = *(const u32x4*)(kg0 + i * KGS + (size_t)(kt + 1) * 64 * DM * 2); vreg[i] = *(const u32x4*)(vg0 + i * VGS + (size_t)(kt + 1) * 128); }
        }
        attn_step<16, true>(lds + sm * 256, DA_KS, lds + DA_VOFF, DA_VS, qf, o, m, l, SC2, sl2, c * 64 + rg * 16 + fr, kt * 64, 64, lane);
    }
    bf16_t* orow = (bf16_t*)(ws + W_OA) + (size_t)qrow * DM + h * 256;
    diff_finalize<16>(o, l, sm, rg, 0, false, lam, p.in[15], orow, lds, lane);
}

DEV void diffattn_sample_item(const P& p, LAS unsigned char* lds, int b, int h, float lam) {
    const int tid = get_tid(), wid = __builtin_amdgcn_readfirstlane(tid >> 6), lane = tid & 63, fr = lane & 15, g = lane >> 4;
    const int sm = wid & 1, eq = wid >> 1;
    unsigned char* ws = p.ws;
    const bf16_t* QB = (const bf16_t*)(ws + W_QB); const bf16_t* KBb = (const bf16_t*)(ws + W_KB);
    const float* ck = p.in[3]; const float* cv = p.in[4]; const float* nv = p.out + O_DVS;
    const int qrow = MP + b * ST + fr;
    bf16x8 qf[4];
#pragma unroll
    for (int ks = 0; ks < 4; ++ks) qf[ks] = *(const bf16x8*)(QB + (size_t)qrow * DM + h * 256 + sm * 128 + ks * 32 + g * 8);
    f32x4 o[4];
#pragma unroll
    for (int e = 0; e < 4; ++e) o[e] = (f32x4){0.f, 0.f, 0.f, 0.f};
    float m = -INFINITY, l = 0.f;
    const float sl2 = ex2(-(float)(h + 1)) * LOG2E;
    const int vkey = tid & 63, vseg = tid >> 6;
    const float* kbase = ck + ((size_t)(b * PAST + (tid >> 6)) * 8 + h) * 256 + (tid & 63) * 4;
    const float* vbase = cv + ((size_t)(b * PAST + vkey) * 8 + h) * 256 + vseg * 32;
    constexpr size_t ROWF = 8 * 256;
    f32x4 kr[8], vr[8];
#pragma unroll
    for (int i = 0; i < 8; ++i) { kr[i] = *(const f32x4*)(kbase + (size_t)i * 8 * ROWF); vr[i] = *(const f32x4*)(vbase + i * 4); }
    for (int kt = 0; kt < 16; ++kt) {
        __syncthreads();
#pragma unroll
        for (int i = 0; i < 8; ++i) { const int kr_ = (tid >> 6) + 8 * i, kc = tid & 63;
            *(LAS u32x2*)(lds + kr_ * DA_KS + kc * 8) = pk4(kr[i]);
            const u32x2 pk = pk4(vr[i]); LAS unsigned char* d = lds + DA_VOFF + (vseg * 32 + i * 4) * DA_VS + vkey * 2;
            *(LAS bf16_t*)(d) = (bf16_t)(pk.x & 0xffff); *(LAS bf16_t*)(d + DA_VS) = (bf16_t)(pk.x >> 16); *(LAS bf16_t*)(d + 2 * DA_VS) = (bf16_t)(pk.y & 0xffff); *(LAS bf16_t*)(d + 3 * DA_VS) = (bf16_t)(pk.y >> 16); }
        __syncthreads();
        if (kt < 15) {
#pragma unroll
            for (int i = 0; i < 8; ++i) { kr[i] = *(const f32x4*)(kbase + ((size_t)(kt + 1) * 64 + i * 8) * ROWF); vr[i] = *(const f32x4*)(vbase + (size_t)(kt + 1) * 64 * ROWF + i * 4); }
        }
        attn_step<4, true>(lds + sm * 256, DA_KS, lds + DA_VOFF + eq * 64 * DA_VS, DA_VS, qf, o, m, l, SC2, sl2, PAST + fr, kt * 64, 64, lane);
    }
    {
        __syncthreads();
#pragma unroll
        for (int i = 0; i < 4; ++i) { const int id = tid + 512 * i, kr_ = id >> 5, kc = id & 31;
            u32x4 v = (u32x4){0u, 0u, 0u, 0u};
            if (kr_ < 16) v = *(const u32x4*)(KBb + (size_t)(MP + b * ST + kr_) * DM + h * 256 + kc * 8);
            *(LAS u32x4*)(lds + kr_ * DA_KS + kc * 16) = v; }
        { const float* vp = nv + (size_t)(b * ST + (vkey & 15)) * DM + h * 256 + vseg * 32;
#pragma unroll
          for (int i = 0; i < 8; ++i) { f32x4 v = *(const f32x4*)(vp + i * 4); if (vkey >= 16) v = (f32x4){0.f, 0.f, 0.f, 0.f};
              const u32x2 pk = pk4(v); LAS unsigned char* d = lds + DA_VOFF + (vseg * 32 + i * 4) * DA_VS + vkey * 2;
              *(LAS bf16_t*)(d) = (bf16_t)(pk.x & 0xffff); *(LAS bf16_t*)(d + DA_VS) = (bf16_t)(pk.x >> 16); *(LAS bf16_t*)(d + 2 * DA_VS) = (bf16_t)(pk.y & 0xffff); *(LAS bf16_t*)(d + 3 * DA_VS) = (bf16_t)(pk.y >> 16); } }
        __syncthreads();
        attn_step<4, true>(lds + sm * 256, DA_KS, lds + DA_VOFF + eq * 64 * DA_VS, DA_VS, qf, o, m, l, SC2, sl2, PAST + fr, 16 * 64, 16, lane);
    }
    bf16_t* orow = (bf16_t*)(ws + W_OA) + (size_t)qrow * DM + h * 256;
    diff_finalize<4>(o, l, sm, eq, eq * 64, true, lam, p.in[15], orow, lds, lane);
}

constexpr int XA_KS = 272, XA_VS = 528, XA_VOFF = 256 * XA_KS;
DEV void xattn_prompt_item(const P& p, LAS unsigned char* lds, int b, int h, int tile) {
    const int tid = get_tid(), wid = __builtin_amdgcn_readfirstlane(tid >> 6), lane = tid & 63, fr = lane & 15, g = lane >> 4;
    unsigned char* ws = p.ws;
    const float* QXP = (const float*)(ws + W_QXP); const bf16_t* MK = (const bf16_t*)(ws + W_MEMK); const bf16_t* MVT = (const bf16_t*)(ws + W_MEMVT);
    __syncthreads();
#pragma unroll
    for (int i = 0; i < 8; ++i) { const int id = tid + 512 * i;
        { const int kr = id >> 4, kc = id & 15; *(LAS u32x4*)(lds + kr * XA_KS + kc * 16) = *(const u32x4*)(MK + (size_t)(b * 256 + kr) * 512 + h * 128 + kc * 8); }
        { const int ve = id >> 5, vc = id & 31; *(LAS u32x4*)(lds + XA_VOFF + ve * XA_VS + vc * 16) = *(const u32x4*)(MVT + (size_t)(b * 512 + h * 128 + ve) * 256 + vc * 8); } }
    __syncthreads();
    const int row = b * SEQ + tile * 128 + wid * 16 + fr;
    bf16x8 qf[4];
#pragma unroll
    for (int ks = 0; ks < 4; ++ks) { const float* qp = QXP + (size_t)row * XW + h * 128 + ks * 32 + g * 8; f32x4 a0 = *(const f32x4*)qp, a1 = *(const f32x4*)(qp + 4);
#pragma unroll
        for (int pz = 1; pz < 2; ++pz) { a0 = a0 + *(const f32x4*)(qp + (size_t)pz * MT * XW); a1 = a1 + *(const f32x4*)(qp + (size_t)pz * MT * XW + 4); }
        u32x4 w; w.x = pk_bf16(a0[0], a0[1]); w.y = pk_bf16(a0[2], a0[3]); w.z = pk_bf16(a1[0], a1[1]); w.w = pk_bf16(a1[2], a1[3]); qf[ks] = __builtin_bit_cast(bf16x8, w); }
    f32x4 o[8];
#pragma unroll
    for (int e = 0; e < 8; ++e) o[e] = (f32x4){0.f, 0.f, 0.f, 0.f};
    float m = -INFINITY, l = 0.f;
#pragma unroll 1
    for (int kt = 0; kt < 4; ++kt)
        attn_step<8, false>(lds + kt * 64 * XA_KS, XA_KS, lds + XA_VOFF + kt * 128, XA_VS, qf, o, m, l, SC2, 0.f, 0, 0, 64, lane);
    l += __shfl_xor(l, 16); l += __shfl_xor(l, 32);
    const float inv = 1.0f / l;
    bf16_t* orow = (bf16_t*)(ws + W_OX) + (size_t)row * XW + h * 128;
#pragma unroll
    for (int et = 0; et < 8; ++et) *(u32x2*)(orow + et * 16 + g * 4) = pk4(o[et] * inv);
}
DEV void xattn_sample_item(const P& p, LAS unsigned char* lds, int b, int h) {
    const int tid = get_tid(), wid = __builtin_amdgcn_readfirstlane(tid >> 6), lane = tid & 63, fr = lane & 15, g = lane >> 4;
    unsigned char* ws = p.ws;
    const float* QXP = (const float*)(ws + W_QXP); const float* mk = p.in[7]; const float* mv = p.in[8];
    __syncthreads();
#pragma unroll
    for (int i = 0; i < 16; ++i) { const int id = tid + 512 * i, kr = id >> 5, kc = id & 31;
        const f32x4 v = *(const f32x4*)(mk + ((size_t)(b * 256 + kr) * 4 + h) * 128 + kc * 4);
        *(LAS u32x2*)(lds + kr * XA_KS + kc * 8) = pk4(v);
        const f32x4 w = *(const f32x4*)(mv + ((size_t)(b * 256 + kr) * 4 + h) * 128 + kc * 4); const u32x2 pk = pk4(w);
        LAS unsigned char* d = lds + XA_VOFF + (kc * 4) * XA_VS + kr * 2;
        *(LAS bf16_t*)(d) = (bf16_t)(pk.x & 0xffff); *(LAS bf16_t*)(d + XA_VS) = (bf16_t)(pk.x >> 16); *(LAS bf16_t*)(d + 2 * XA_VS) = (bf16_t)(pk.y & 0xffff); *(LAS bf16_t*)(d + 3 * XA_VS) = (bf16_t)(pk.y >> 16); }
    __syncthreads();
    if (wid == 0) {
        const int row = MP + b * ST + fr;
        bf16x8 qf[4];
#pragma unroll
        for (int ks = 0; ks < 4; ++ks) { const float* qp = QXP + (size_t)row * XW + h * 128 + ks * 32 + g * 8; f32x4 a0 = *(const f32x4*)qp, a1 = *(const f32x4*)(qp + 4);
#pragma unroll
        for (int pz = 1; pz < 2; ++pz) { a0 = a0 + *(const f32x4*)(qp + (size_t)pz * MT * XW); a1 = a1 + *(const f32x4*)(qp + (size_t)pz * MT * XW + 4); }
        u32x4 w; w.x = pk_bf16(a0[0], a0[1]); w.y = pk_bf16(a0[2], a0[3]); w.z = pk_bf16(a1[0], a1[1]); w.w = pk_bf16(a1[2], a1[3]); qf[ks] = __builtin_bit_cast(bf16x8, w); }
        f32x4 o[8];
#pragma unroll
        for (int e = 0; e < 8; ++e) o[e] = (f32x4){0.f, 0.f, 0.f, 0.f};
        float m = -INFINITY, l = 0.f;
#pragma unroll 1
        for (int kt = 0; kt < 4; ++kt)
            attn_step<8, false>(lds + kt * 64 * XA_KS, XA_KS, lds + XA_VOFF + kt * 128, XA_VS, qf, o, m, l, SC2, 0.f, 0, 0, 64, lane);
        l += __shfl_xor(l, 16); l += __shfl_xor(l, 32);
        const float inv = 1.0f / l;
        bf16_t* orow = (bf16_t*)(ws + W_OX) + (size_t)row * XW + h * 128;
#pragma unroll
        for (int et = 0; et < 8; ++et) *(u32x2*)(orow + et * 16 + g * 4) = pk4(o[et] * inv);
    }
}

constexpr int GA_QS = 512, GA_KS = 17920, GA_MS = 35328, GA_RHS = 51712;
constexpr float QSCALE = 0.08838834764831845f;

DEV void conv16(const P& p, bool sample, int b, int tseq, int rowbase, int ch, float (&acc)[16]) {
    const bf16_t* GB = (const bf16_t*)(p.ws + W_GB); const float* cw = p.in[10]; const float* cbuf = p.in[6];
#pragma unroll
    for (int i = 0; i < 16; ++i) acc[i] = 0.f;
#pragma unroll 1
    for (int j = 0; j < 4; ++j) { const int tt = tseq - 3 + j;
        float x[16];
        if (tt >= 0) { const u32x4 a = *(const u32x4*)(GB + (size_t)(rowbase + tt) * 6144 + ch), c = *(const u32x4*)(GB + (size_t)(rowbase + tt) * 6144 + ch + 8);
            x[0] = bflo(a.x); x[1] = bfhi(a.x); x[2] = bflo(a.y); x[3] = bfhi(a.y); x[4] = bflo(a.z); x[5] = bfhi(a.z); x[6] = bflo(a.w); x[7] = bfhi(a.w);
            x[8] = bflo(c.x); x[9] = bfhi(c.x); x[10] = bflo(c.y); x[11] = bfhi(c.y); x[12] = bflo(c.z); x[13] = bfhi(c.z); x[14] = bflo(c.w); x[15] = bfhi(c.w);
        } else if (sample) { const float* s = cbuf + ((size_t)b * 3 + (3 + tt)) * 6144 + ch;
#pragma unroll
            for (int q = 0; q < 4; ++q) { const f32x4 v = *(const f32x4*)(s + q * 4); x[q * 4] = v[0]; x[q * 4 + 1] = v[1]; x[q * 4 + 2] = v[2]; x[q * 4 + 3] = v[3]; }
        } else {
#pragma unroll
            for (int i = 0; i < 16; ++i) x[i] = 0.f;
        }
#pragma unroll
        for (int q = 0; q < 4; ++q) { const f32x4 w = *(const f32x4*)(cw + (size_t)j * 6144 + ch + q * 4);
            acc[q * 4] += w[0] * x[q * 4]; acc[q * 4 + 1] += w[1] * x[q * 4 + 1]; acc[q * 4 + 2] += w[2] * x[q * 4 + 2]; acc[q * 4 + 3] += w[3] * x[q * 4 + 3]; }
    }
#pragma unroll
    for (int i = 0; i < 16; ++i) acc[i] = siluf_(acc[i]);
}

constexpr int GA_XRAW = GA_MS, GA_XS = 784, GA_WL = 117248;
DEV void conv16_lds(const LAS unsigned char* lds, int tensor, int t, int d0, float (&acc)[16]) {
#pragma unroll
    for (int i = 0; i < 16; ++i) acc[i] = 0.f;
#pragma unroll
    for (int j = 0; j < 4; ++j) {
        const LAS unsigned char* xp = lds + GA_XRAW + (t + j) * GA_XS + tensor * 256 + d0 * 2;
        const u32x4 a = *(const LAS u32x4*)xp, c = *(const LAS u32x4*)(xp + 16);
        const float x[16] = {bflo(a.x), bfhi(a.x), bflo(a.y), bfhi(a.y), bflo(a.z), bfhi(a.z), bflo(a.w), bfhi(a.w), bflo(c.x), bfhi(c.x), bflo(c.y), bfhi(c.y), bflo(c.z), bfhi(c.z), bflo(c.w), bfhi(c.w)};
        const LAS float* wp = (const LAS float*)(lds + GA_WL) + (tensor * 4 + j) * 128 + d0;
#pragma unroll
        for (int q = 0; q < 4; ++q) { const f32x4 w = *(const LAS f32x4*)(wp + q * 4);
            acc[q * 4] += w[0] * x[q * 4]; acc[q * 4 + 1] += w[1] * x[q * 4 + 1]; acc[q * 4 + 2] += w[2] * x[q * 4 + 2]; acc[q * 4 + 3] += w[3] * x[q * 4 + 3]; }
    }
#pragma unroll
    for (int i = 0; i < 16; ++i) acc[i] = siluf_(acc[i]);
}

template <int C>
DEV void gdn_a_item(const P& p, LAS unsigned char* lds, bool sample, int b, int n, int h, unsigned char* item, float* decp) {
    constexpr int CP = C < 32 ? 32 : C;
    constexpr size_t OFF_W = 0, OFF_UT = (size_t)C * 256, OFF_QG = (size_t)C * 512, OFF_QK = (size_t)C * 768, OFF_KDT = OFF_QK + (size_t)C * CP * 2;
    const int tid = get_tid(), wid = __builtin_amdgcn_readfirstlane(tid >> 6), lane = tid & 63, fr = lane & 15, g = lane >> 4;
    LAS float* GC = (LAS float*)lds; LAS float* BETA = (LAS float*)(lds + 256);
    LAS float* Ms = (LAS float*)(lds + GA_MS); LAS float* RHS = (LAS float*)(lds + GA_RHS);
    const int rowbase = sample ? MP + b * ST : b * SEQ;
    const int t0 = sample ? 0 : n * 64;
    __syncthreads();
    {
        const bf16_t* GB = (const bf16_t*)(p.ws + W_GB);
        constexpr int NCH = (C + 3) * 48, NIT = (NCH + 511) / 512;
        u32x4 sv[NIT];
#pragma unroll
        for (int k = 0; k < NIT; ++k) { const int id = tid + 512 * k; sv[k] = (u32x4){0u, 0u, 0u, 0u};
            if (id < NCH) { const int r = id / 48, c = id % 48, tensor = c >> 4, cc = c & 15; const int tt = t0 - 3 + r;
                const int ch = tensor * 2048 + h * 128 + cc * 8;
                if (tt >= 0) sv[k] = *(const u32x4*)(GB + (size_t)(rowbase + tt) * 6144 + ch);
                else if (sample) { const float* sp = p.in[6] + ((size_t)b * 3 + (3 + tt)) * 6144 + ch; const f32x4 f0 = *(const f32x4*)sp, f1 = *(const f32x4*)(sp + 4);
                    sv[k].x = pk_bf16(f0[0], f0[1]); sv[k].y = pk_bf16(f0[2], f0[3]); sv[k].z = pk_bf16(f1[0], f1[1]); sv[k].w = pk_bf16(f1[2], f1[3]); } } }
#pragma unroll
        for (int k = 0; k < NIT; ++k) { const int id = tid + 512 * k;
            if (id < NCH) { const int r = id / 48, c = id % 48, tensor = c >> 4, cc = c & 15; *(LAS u32x4*)(lds + GA_XRAW + r * GA_XS + tensor * 256 + cc * 16) = sv[k]; } }
        if (tid < 384) { const int tensor = tid >> 7, rem = tid & 127, j = rem >> 5, d4 = (rem & 31) * 4;
            *(LAS f32x4*)(lds + GA_WL + ((tensor * 4 + j) * 128 + d4) * 4) = *(const f32x4*)(p.in[10] + (size_t)j * 6144 + tensor * 2048 + h * 128 + d4); }
    }
    if (tid < 64) {
        float gv = 0.f, bt = 0.f;
        if (tid < C) { const float* gab = (const float*)(p.ws + W_GAB) + (size_t)(rowbase + t0 + tid) * 32;
            const float ga = gab[h] + p.in[17][h], gb = gab[16 + h];
            const float sp = ga > 20.f ? ga : log1pf(__expf(ga));
            gv = -__expf(p.in[16][h]) * sp; bt = sigmoidf_(gb); }
#pragma unroll
        for (int o = 1; o < 64; o <<= 1) { const float u = __shfl_up(gv, o); if (lane >= o) gv += u; }
        if (tid < C) { GC[tid] = gv; BETA[tid] = bt; }
    }
    __syncthreads();
    const int t = tid >> 3, part = tid & 7;
    const int d0 = part * 16;
    float q[16], k[16], v[16];
    if (t < C) {
        conv16_lds(lds, 0, t, d0, q);
        conv16_lds(lds, 1, t, d0, k);
        conv16_lds(lds, 2, t, d0, v);
    }
    __syncthreads();
    if (t < C) {
        const float gcv = GC[t], beta = BETA[t], glast = GC[C - 1];
        float sq = 0.f, sk = 0.f;
#pragma unroll
        for (int i = 0; i < 16; ++i) { sq += q[i] * q[i]; sk += k[i] * k[i]; }
#pragma unroll
        for (int o = 1; o < 8; o <<= 1) { sq += __shfl_xor(sq, o); sk += __shfl_xor(sk, o); }
        const float rq = rsqrtf(sq + 1e-6f) * QSCALE, rk = rsqrtf(sk + 1e-6f);
        const float eg = __expf(gcv), ekd = __expf(glast - gcv);
#pragma unroll
        for (int i = 0; i < 16; ++i) { q[i] *= rq; k[i] *= rk; }
        u32x4 w0, w1;
        w0.x = pk_bf16(q[0], q[1]); w0.y = pk_bf16(q[2], q[3]); w0.z = pk_bf16(q[4], q[5]); w0.w = pk_bf16(q[6], q[7]);
        w1.x = pk_bf16(q[8], q[9]); w1.y = pk_bf16(q[10], q[11]); w1.z = pk_bf16(q[12], q[13]); w1.w = pk_bf16(q[14], q[15]);
        *(LAS u32x4*)(lds + GA_QS + t * 272 + d0 * 2) = w0; *(LAS u32x4*)(lds + GA_QS + t * 272 + d0 * 2 + 16) = w1;
        w0.x = pk_bf16(k[0], k[1]); w0.y = pk_bf16(k[2], k[3]); w0.z = pk_bf16(k[4], k[5]); w0.w = pk_bf16(k[6], k[7]);
        w1.x = pk_bf16(k[8], k[9]); w1.y = pk_bf16(k[10], k[11]); w1.z = pk_bf16(k[12], k[13]); w1.w = pk_bf16(k[14], k[15]);
        *(LAS u32x4*)(lds + GA_KS + t * 272 + d0 * 2) = w0; *(LAS u32x4*)(lds + GA_KS + t * 272 + d0 * 2 + 16) = w1;
        w0.x = pk_bf16(q[0] * eg, q[1] * eg); w0.y = pk_bf16(q[2] * eg, q[3] * eg); w0.z = pk_bf16(q[4] * eg, q[5] * eg); w0.w = pk_bf16(q[6] * eg, q[7] * eg);
        w1.x = pk_bf16(q[8] * eg, q[9] * eg); w1.y = pk_bf16(q[10] * eg, q[11] * eg); w1.z = pk_bf16(q[12] * eg, q[13] * eg); w1.w = pk_bf16(q[14] * eg, q[15] * eg);
        *(u32x4*)(item + OFF_QG + ((size_t)t * 128 + d0) * 2) = w0; *(u32x4*)(item + OFF_QG + ((size_t)t * 128 + d0) * 2 + 16) = w1;
        bf16_t* kdt = (bf16_t*)(item + OFF_KDT);
        const float bg = beta * eg;
#pragma unroll
        for (int i = 0; i < 16; ++i) { kdt[(size_t)(d0 + i) * CP + t] = (bf16_t)(pk_bf16(k[i] * ekd, 0.f) & 0xffff);
            RHS[t * 256 + d0 + i] = v[i] * beta; RHS[t * 256 + 128 + d0 + i] = k[i] * bg; }
    } else if (C < CP && t < CP) {
        bf16_t* kdt = (bf16_t*)(item + OFF_KDT);
#pragma unroll
        for (int i = 0; i < 16; ++i) kdt[(size_t)(part * 16 + i) * CP + t] = 0;
    }
    if (C < CP) { bf16_t* qk = (bf16_t*)(item + OFF_QK); for (int idx = tid; idx < C * (CP - C); idx += 512) qk[(idx / (CP - C)) * CP + C + idx % (CP - C)] = 0; }
    if (tid == 0) *decp = __expf(GC[C - 1]);
    __syncthreads();
    constexpr int NTI = C / 16, NTL = NTI * NTI * 2;
    for (int id = wid; id < NTL; id += 8) {
        const int which = id / (NTI * NTI), it = (id / NTI) % NTI, jt = id % NTI;
        const LAS unsigned char* Ab = lds + (which ? GA_QS : GA_KS) + (it * 16 + fr) * 272 + g * 16;
        const LAS unsigned char* Bb = lds + GA_KS + (jt * 16 + fr) * 272 + g * 16;
        f32x4 d = (f32x4){0.f, 0.f, 0.f, 0.f};
#pragma unroll
        for (int ks = 0; ks < 4; ++ks) d = __builtin_amdgcn_mfma_f32_16x16x32_bf16(*(const LAS bf16x8*)(Ab + ks * 64), *(const LAS bf16x8*)(Bb + ks * 64), d, 0, 0, 0);
        const int j = jt * 16 + fr; const float gj = GC[j];
#pragma unroll
        for (int jj = 0; jj < 4; ++jj) { const int i = it * 16 + g * 4 + jj; const float dec = __expf(GC[i] - gj);
            if (which == 0) Ms[i * C + j] = (i > j) ? BETA[i] * d[jj] * dec : 0.f;
            else ((bf16_t*)(item + OFF_QK))[(size_t)i * CP + j] = (bf16_t)(pk_bf16((i >= j) ? d[jj] * dec : 0.f, 0.f) & 0xffff); }
    }
    __syncthreads();
    if (tid < 256) {
        float s[C];
#pragma unroll
        for (int i = 0; i < C; ++i) s[i] = 0.f;
#pragma unroll
        for (int i = 0; i < C; ++i) { float a = RHS[i * 256 + tid];
#pragma unroll
            for (int j4 = 0; j4 < (i + 3) / 4; ++j4) { const f32x4 mv = *(const LAS f32x4*)(Ms + i * C + j4 * 4);
                a -= mv[0] * s[j4 * 4] + mv[1] * s[j4 * 4 + 1] + mv[2] * s[j4 * 4 + 2] + mv[3] * s[j4 * 4 + 3]; }
            s[i] = a; }
        if (tid < 128) { unsigned char* ut = item + OFF_UT + (size_t)tid * C * 2;
#pragma unroll
            for (int i = 0; i < C; i += 8) { u32x4 w; w.x = pk_bf16(s[i], s[i + 1]); w.y = pk_bf16(s[i + 2], s[i + 3]); w.z = pk_bf16(s[i + 4], s[i + 5]); w.w = pk_bf16(s[i + 6], s[i + 7]); *(u32x4*)(ut + i * 2) = w; }
        } else { bf16_t* wp = (bf16_t*)(item + OFF_W) + (tid - 128);
#pragma unroll
            for (int i = 0; i < C; ++i) wp[(size_t)i * 128] = (bf16_t)(pk_bf16(s[i], 0.f) & 0xffff); }
    }
}

constexpr int GB_W = 0, GB_QG = 17408, GB_QK = 34816, GB_KDT = 44032, GB_ST = 62464, GB_VNT = 97280, GB_OS = 115712;
template <int C>
DEV void gdn_scan_chain(const P& p, LAS unsigned char* lds, bool sample, int b, int h) {
    constexpr int CP = C < 32 ? 32 : C, RS = CP * 2 + 16, NCT = C / 16, NKK = CP / 32;
    constexpr size_t OFF_W = 0, OFF_UT = (size_t)C * 256, OFF_QG = (size_t)C * 512, OFF_QK = (size_t)C * 768, OFF_KDT = OFF_QK + (size_t)C * CP * 2, ISZ = OFF_KDT + (size_t)128 * CP * 2;
    const int tid = get_tid(), wid = __builtin_amdgcn_readfirstlane(tid >> 6), lane = tid & 63, fr = lane & 15, g = lane >> 4;
    const int et = wid, e = et * 16 + fr;
    unsigned char* ws = p.ws;
    f32x4 sreg[8];
    __syncthreads();
    for (int i = tid; i < 128 * RS / 4; i += 512) ((LAS unsigned*)(lds + GB_VNT))[i] = 0u;
    if (sample) { const float* s0 = p.in[5] + (size_t)(b * 16 + h) * 16384;
#pragma unroll
        for (int dt = 0; dt < 8; ++dt)
#pragma unroll
            for (int j = 0; j < 4; ++j) sreg[dt][j] = s0[(size_t)(dt * 16 + g * 4 + j) * 128 + e];
    } else {
#pragma unroll
        for (int dt = 0; dt < 8; ++dt) sreg[dt] = (f32x4){0.f, 0.f, 0.f, 0.f};
    }
#pragma unroll
    for (int dt = 0; dt < 8; ++dt) *(LAS u32x2*)(lds + GB_ST + e * 272 + (dt * 16 + g * 4) * 2) = pk4(sreg[dt]);
    const int nchunk = sample ? 1 : 32;
    for (int n = 0; n < nchunk; ++n) {
        const int itemi = sample ? (b * 16 + h) : ((b * 32 + n) * 16 + h);
        const unsigned char* item = sample ? ws + W_GDNS + (size_t)itemi * ISZ : ws + W_GDN + (size_t)itemi * ISZ;
        const float dec = __hip_atomic_load((const float*)(ws + W_DEC) + (sample ? 2048 + itemi : itemi), __ATOMIC_RELAXED, __HIP_MEMORY_SCOPE_AGENT);
        const int row0 = sample ? MP + b * ST : b * SEQ + n * 64;
        __syncthreads();
        for (int id = tid; id < C * 16; id += 512) { const int r = id >> 4, c = id & 15;
            *(LAS u32x4*)(lds + GB_W + r * 272 + c * 16) = *(const u32x4*)(item + OFF_W + (size_t)r * 256 + c * 16);
            *(LAS u32x4*)(lds + GB_QG + r * 272 + c * 16) = *(const u32x4*)(item + OFF_QG + (size_t)r * 256 + c * 16); }
        for (int id = tid; id < C * (CP / 8); id += 512) { const int r = id / (CP / 8), c = id % (CP / 8);
            *(LAS u32x4*)(lds + GB_QK + r * RS + c * 16) = *(const u32x4*)(item + OFF_QK + (size_t)r * CP * 2 + c * 16); }
        for (int id = tid; id < 128 * (CP / 8); id += 512) { const int r = id / (CP / 8), c = id % (CP / 8);
            *(LAS u32x4*)(lds + GB_KDT + r * RS + c * 16) = *(const u32x4*)(item + OFF_KDT + (size_t)r * CP * 2 + c * 16); }
        u32x2 uu[NCT];
#pragma unroll
        for (int ct = 0; ct < NCT; ++ct) uu[ct] = *(const u32x2*)(item + OFF_UT + ((size_t)e * C + ct * 16 + g * 4) * 2);
        __syncthreads();
        bf16x8 sf[4];
#pragma unroll
        for (int ks = 0; ks < 4; ++ks) sf[ks] = *(const LAS bf16x8*)(lds + GB_ST + e * 272 + ks * 64 + g * 16);
#pragma unroll
        for (int ct = 0; ct < NCT; ++ct) { f32x4 d = (f32x4){0.f, 0.f, 0.f, 0.f};
#pragma unroll
            for (int ks = 0; ks < 4; ++ks) d = __builtin_amdgcn_mfma_f32_16x16x32_bf16(*(const LAS bf16x8*)(lds + GB_W + (ct * 16 + fr) * 272 + ks * 64 + g * 16), sf[ks], d, 0, 0, 0);
            f32x4 vn; vn[0] = bflo(uu[ct].x) - d[0]; vn[1] = bfhi(uu[ct].x) - d[1]; vn[2] = bflo(uu[ct].y) - d[2]; vn[3] = bfhi(uu[ct].y) - d[3];
            *(LAS u32x2*)(lds + GB_VNT + e * RS + (ct * 16 + g * 4) * 2) = pk4(vn); }
        __syncthreads();
        bf16x8 vf[NKK];
#pragma unroll
        for (int kk = 0; kk < NKK; ++kk) vf[kk] = *(const LAS bf16x8*)(lds + GB_VNT + e * RS + kk * 64 + g * 16);
#pragma unroll
        for (int ct = 0; ct < NCT; ++ct) { f32x4 d = (f32x4){0.f, 0.f, 0.f, 0.f};
#pragma unroll
            for (int ks = 0; ks < 4; ++ks) d = __builtin_amdgcn_mfma_f32_16x16x32_bf16(*(const LAS bf16x8*)(lds + GB_QG + (ct * 16 + fr) * 272 + ks * 64 + g * 16), sf[ks], d, 0, 0, 0);
#pragma unroll
            for (int kk = 0; kk < NKK; ++kk) d = __builtin_amdgcn_mfma_f32_16x16x32_bf16(*(const LAS bf16x8*)(lds + GB_QK + (ct * 16 + fr) * RS + kk * 64 + g * 16), vf[kk], d, 0, 0, 0);
#pragma unroll
            for (int j = 0; j < 4; ++j) ((LAS bf16_t*)(lds + GB_W))[(ct * 16 + g * 4 + j) * 136 + e] = (bf16_t)(pk_bf16(d[j], 0.f) & 0xffff); }
#pragma unroll
        for (int dt = 0; dt < 8; ++dt) { f32x4 d = sreg[dt] * dec;
#pragma unroll
            for (int kk = 0; kk < NKK; ++kk) d = __builtin_amdgcn_mfma_f32_16x16x32_bf16(*(const LAS bf16x8*)(lds + GB_KDT + (dt * 16 + fr) * RS + kk * 64 + g * 16), vf[kk], d, 0, 0, 0);
            sreg[dt] = d; }
        __syncthreads();
#pragma unroll
        for (int dt = 0; dt < 8; ++dt) *(LAS u32x2*)(lds + GB_ST + e * 272 + (dt * 16 + g * 4) * 2) = pk4(sreg[dt]);
        { const int t = tid >> 3, part = tid & 7;
          if (t < C) { const LAS unsigned char* op = lds + GB_W + t * 272 + part * 32; float ov[16]; float ss = 0.f;
              const u32x4 o0 = *(const LAS u32x4*)op, o1 = *(const LAS u32x4*)(op + 16);
              const unsigned owd[8] = {o0.x, o0.y, o0.z, o0.w, o1.x, o1.y, o1.z, o1.w};
#pragma unroll
              for (int i = 0; i < 8; ++i) { ov[2 * i] = bflo(owd[i]); ov[2 * i + 1] = bfhi(owd[i]); }
#pragma unroll
              for (int i = 0; i < 16; ++i) ss += ov[i] * ov[i];
#pragma unroll
              for (int o = 1; o < 8; o <<= 1) ss += __shfl_xor(ss, o);
              const float r = rsqrtf(ss * (1.0f / 128.0f) + 1e-6f);
              const size_t off = (size_t)(row0 + t) * DM + h * 128 + part * 16;
              const bf16_t* Z = (const bf16_t*)(ws + W_ZB) + off; const float* gn = p.in[18] + part * 16;
              const u32x4 z0 = *(const u32x4*)Z, z1 = *(const u32x4*)(Z + 8);
              const unsigned zw[8] = {z0.x, z0.y, z0.z, z0.w, z1.x, z1.y, z1.z, z1.w};
              unsigned ow[8];
#pragma unroll
              for (int i = 0; i < 8; ++i) { const float a = ov[2 * i] * r * gn[2 * i] * siluf_(bflo(zw[i])), c2 = ov[2 * i + 1] * r * gn[2 * i + 1] * siluf_(bfhi(zw[i])); ow[i] = pk_bf16(a, c2); }
              bf16_t* O = (bf16_t*)(ws + W_OB) + off;
              *(u32x4*)O = (u32x4){ow[0], ow[1], ow[2], ow[3]}; *(u32x4*)(O + 8) = (u32x4){ow[4], ow[5], ow[6], ow[7]}; } }
        __syncthreads();
    }
    float* so = p.out + (sample ? O_GSS : O_GSP) + (size_t)(b * 16 + h) * 16384;
#pragma unroll
    for (int dt = 0; dt < 8; ++dt)
#pragma unroll
        for (int j = 0; j < 4; ++j) so[(size_t)(dt * 16 + g * 4 + j) * 128 + e] = sreg[dt][j];
}

#define XB_TMO      128
#define XB_XCNT(j)  (256  + 64 * (j))
#define XB_XSUB(j)  (1280 + 64 * (j))
#define XB_XGEN(j)  (2304 + 64 * (j))
#define XB_TOP      3328
#define XB_TOPGEN   3392
#define XB_SPIN_CAP (1u << 18)
DEV unsigned xb_ld(unsigned* p)              { return __hip_atomic_load(p, __ATOMIC_RELAXED, __HIP_MEMORY_SCOPE_AGENT); }
DEV unsigned xb_add(unsigned* p, unsigned v) { return __hip_atomic_fetch_add(p, v, __ATOMIC_RELAXED, __HIP_MEMORY_SCOPE_AGENT); }
DEV unsigned xb_xcc_id() { return (unsigned)__builtin_amdgcn_s_getreg((3 << 11) | 20) & 0xFu; }
#define XB_SPIN(cond, bar) do { unsigned _sp = 0; while (cond) { __builtin_amdgcn_s_sleep(1); \
    if ((++_sp & 255u) == 0u) { if (xb_ld(&(bar)[XB_TMO])) break; if (_sp > XB_SPIN_CAP) { atomicAdd(&(bar)[XB_TMO], 1u); break; } } } } while (0)
struct XcdBarrier { unsigned* bar; unsigned x; volatile LAS unsigned* st; };
DEV XcdBarrier xcd_barrier_post(unsigned* bar, volatile LAS unsigned* st) {
    XcdBarrier b; b.bar = bar; b.x = xb_xcc_id(); b.st = st;
    if (threadIdx.x == 0) (void)xb_add(&bar[XB_XCNT(b.x)], 1u);
    return b;
}
DEV void xcd_barrier_complete(unsigned* bar, unsigned x, unsigned& nloc, unsigned& nx) {
    const unsigned G = gridDim.x * gridDim.y * gridDim.z;
    unsigned sum, cnt, mine, sp = 0u;
    for (;;) {
        sum = 0u; cnt = 0u; mine = 0u;
#pragma unroll
        for (unsigned j = 0; j < 16; ++j) { const unsigned c = xb_ld(&bar[XB_XCNT(j)]); sum += c; cnt += (c > 0u) ? 1u : 0u; mine = (j == x) ? c : mine; }
        if (sum == G) break;
        __builtin_amdgcn_s_sleep(1);
        if ((++sp & 255u) == 0u) { if (xb_ld(&bar[XB_TMO])) break; if (sp > XB_SPIN_CAP) { atomicAdd(&bar[XB_TMO], 1u); break; } }
    }
    nloc = mine > 0u ? mine : 1u; nx = cnt > 0u ? cnt : 1u;
}
DEV void xcd_barrier(const XcdBarrier& b) {
    asm volatile("s_waitcnt vmcnt(0)" ::: "memory");
    __syncthreads();
    if (threadIdx.x == 0) {
        unsigned* bar = b.bar;
        __builtin_amdgcn_s_waitcnt(0);
        unsigned nloc = b.st[0], nx = b.st[1];
        if (nloc == 0u) { xcd_barrier_complete(bar, b.x, nloc, nx); b.st[0] = nloc; b.st[1] = nx; }
        const unsigned old = xb_add(&bar[XB_XSUB(b.x)], 1u);
        const unsigned gen = old / nloc;
        if (old + 1u == (gen + 1u) * nloc) {
            __builtin_amdgcn_fence(__ATOMIC_RELEASE, "agent");
            asm volatile("s_waitcnt vmcnt(0)" ::: "memory");
            const unsigned og = xb_add(&bar[XB_TOP], 1u);
            const unsigned tg = og / nx;
            if (og + 1u == (tg + 1u) * nx) xb_add(&bar[XB_TOPGEN], 1u);
            else XB_SPIN(xb_ld(&bar[XB_TOPGEN]) == tg, bar);
            __builtin_amdgcn_fence(__ATOMIC_ACQUIRE, "agent");
            xb_add(&bar[XB_XGEN(b.x)], 1u);
            asm volatile("s_waitcnt vmcnt(0)" ::: "memory");
        } else {
            XB_SPIN(xb_ld(&bar[XB_XGEN(b.x)]) == gen, bar);
            __builtin_amdgcn_fence(__ATOMIC_ACQUIRE, "agent");
            asm volatile("s_waitcnt vmcnt(0)" ::: "memory");
        }
    }
    __syncthreads();
}

#ifndef MK_PER_PHASE
#define MK_PER_PHASE 0
#endif
constexpr int NPHASE = 14;
#ifndef PH_MASK
#define PH_MASK 0xffff
#endif
#define PH_ON(k) ((PH_MASK >> (k)) & 1)

DEV int queue_pop(int* ctr, LAS unsigned char* lds) {
    __syncthreads();
    if (get_tid() == 0) *(LAS int*)(lds + LDS_BYTES - 16) = atomicAdd(ctr, 1);
    __syncthreads();
    return *(LAS int*)(lds + LDS_BYTES - 16);
}
DEV void phase_fn0(const P* pp, LAS unsigned char* lds) {
    const P& p = *pp; unsigned char* ws = p.ws; const int bid = get_bid(), G = gridDim.x; (void)ws; (void)bid; (void)G;
        phase0(p, lds);
}
DEV void phase_fn1(const P* pp, LAS unsigned char* lds) {
    const P& p = *pp; unsigned char* ws = p.ws; const int bid = get_bid(), G = gridDim.x; (void)ws; (void)bid; (void)G;
        EpiProj e1; e1.ws = ws; e1.out = p.out;
        run_gemm(lds, (const bf16_t*)(ws + W_XB), (const bf16_t*)(ws + W_WIN), MT, NPROJ, DM, e1, bid);
        EpiMemKV e2; e2.ws = ws; e2.out = p.out;
        run_gemm(lds, (const bf16_t*)(ws + W_MEMB), (const bf16_t*)(ws + W_WXKV), 1024, 1024, DM, e2, G - 1 - bid);
        for (;;) { const int q = queue_pop((int*)(ws + W_MISC + 200), lds); if (q >= NT_CONV - NT_CONV0) break; conv_job(p, NT_CONV0 + q, (LAS float*)lds); }
}
DEV void phase_fn2(const P* pp, LAS unsigned char* lds) {
    const P& p = *pp; unsigned char* ws = p.ws;
    const float lam = __hip_atomic_load((const float*)(ws + W_MISC), __ATOMIC_RELAXED, __HIP_MEMORY_SCOPE_AGENT);
    int* qctr = (int*)(ws + W_MISC + 192);
    for (;;) {
        const int q = queue_pop(qctr, lds);
        if (q >= 128 + 2304) break;
        if (q < 128) diffattn_sample_item(p, lds, q >> 3, q & 7, lam);
        else { const int it = q - 128;
            if (it < 2048) gdn_a_item<64>(p, lds, false, it >> 9, (it >> 4) & 31, it & 15, ws + W_GDN + (size_t)it * GP_SZ, (float*)(ws + W_DEC) + it);
            else { const int s = it - 2048; gdn_a_item<16>(p, lds, true, s >> 4, 0, s & 15, ws + W_GDN + (size_t)2048 * GP_SZ + (size_t)s * GS_SZ, (float*)(ws + W_DEC) + it); } }
    }
}
DEV void phase_fn3(const P* pp, LAS unsigned char* lds) {
    const P& p = *pp; unsigned char* ws = p.ws;
    const float lam = __hip_atomic_load((const float*)(ws + W_MISC), __ATOMIC_RELAXED, __HIP_MEMORY_SCOPE_AGENT);
    int* qctr = (int*)(ws + W_MISC + 196);
    for (;;) {
        const int q = queue_pop(qctr, lds);
        if (q >= 64 + 256 + 1024) break;
        if (q < 64) gdn_scan_chain<64>(p, lds, false, q >> 4, q & 15);
        else if (q < 320) { const int s = q - 64; gdn_scan_chain<16>(p, lds, true, s >> 4, s & 15); }
        else { const int k = q - 320, c = 31 - (k >> 5), bh = k & 31; diffattn_prompt_item(p, lds, bh >> 3, bh & 7, c, lam); }
    }
}
DEV void phase_fn4(const P* pp, LAS unsigned char* lds) {
    const P& p = *pp; unsigned char* ws = p.ws; const int bid = get_bid(), G = gridDim.x; (void)ws; (void)bid; (void)G;
#ifndef P4M
#define P4M 3
#endif
        { EpiMergeA ea; ea.ws = ws; run_gemm_split(lds, (const bf16_t*)(ws + W_OA), (const bf16_t*)(ws + W_WPA), DM, DM, 1024, ea, nullptr, 0); }
        { EpiMergeB eb; eb.ws = ws; run_gemm_split(lds, (const bf16_t*)(ws + W_OB), (const bf16_t*)(ws + W_WPB), DM, DM, 1024, eb, nullptr, 16); }
}
DEV void phase_fn5(const P* pp, LAS unsigned char* lds) {
    const P& p = *pp; unsigned char* ws = p.ws; const int bid = get_bid(), G = gridDim.x; (void)ws; (void)bid; (void)G;
        EpiResidSplit e; e.PRE = (float*)(ws + W_PRE); e.r0 = p.in[0]; e.rb = nullptr; e.PS = (float*)(ws + W_PS); e.klen = 256;
        bf16_t* scr = (bf16_t*)(ws + W_SCR) + (size_t)bid * MS * DM;
        if (bid < 64) {
            const float* MF = (const float*)(ws + W_PSM); const int kb = (bid >> 3) * 256, tid = get_tid();
            for (int i = tid; i < 256 * 64; i += 512) { const int row = i >> 6, c4 = (i & 63) * 4; const size_t o = (size_t)row * DM + kb + c4;
                const f32x4 v = *(const f32x4*)(MF + o) + *(const f32x4*)(MF + (size_t)MS * DM + o) + *(const f32x4*)(MF + (size_t)2 * MS * DM + o) + *(const f32x4*)(MF + (size_t)3 * MS * DM + o);
                *(u32x2*)(scr + o) = pk4(v); }
            __threadfence(); __syncthreads();
        }
        run_gemm_split(lds, (const bf16_t*)(ws + W_MIX), (const bf16_t*)(ws + W_WO), DM, DM, 256, e, scr, 0);
}
DEV void phase_fn6(const P* pp, LAS unsigned char* lds) {
    const P& p = *pp; unsigned char* ws = p.ws; const int bid = get_bid(), G = gridDim.x; (void)ws; (void)bid; (void)G;
        ln_phase((const float*)(ws + W_PRE), p.in[22], p.in[23], (bf16_t*)(ws + W_H1B), nullptr, p.in[1], nullptr, (const float*)(ws + W_PS), 8);
}
DEV void phase_fn7(const P* pp, LAS unsigned char* lds) {
    const P& p = *pp; unsigned char* ws = p.ws; const int bid = get_bid(), G = gridDim.x; (void)ws; (void)bid; (void)G;
        EpiPart e; e.PS = (float*)(ws + W_QXP); e.ld = XW; e.klen = 1024; e.stride = (size_t)MT * XW;
        pg8::Gemm g; g.A = (const bf16_t*)(ws + W_H1B); g.Bt = (const bf16_t*)(ws + W_WXQ); g.M = MT; g.N = XW; g.K = DM; g.A2 = nullptr;
        pg8::PieceOrder S; S.nM = MT / 256; S.nN = XW / 256; S.G = G; S.c = bid; S.klen = 1024; S.nsplit = 2;
        pg8::gemm_phase(lds, g, S, e);
}
DEV void phase_fn8(const P* pp, LAS unsigned char* lds) {
    const P& p = *pp; unsigned char* ws = p.ws; const int bid = get_bid(), G = gridDim.x; (void)ws; (void)bid; (void)G;
        for (int i = bid; i < 320; i += G) {
            if (i < 256) xattn_prompt_item(p, lds, i >> 6, (i >> 4) & 3, i & 15);
            else { const int s = i - 256; xattn_sample_item(p, lds, s >> 2, s & 3); }
        }
}
DEV void phase_fn9(const P* pp, LAS unsigned char* lds) {
    const P& p = *pp; unsigned char* ws = p.ws; const int bid = get_bid(), G = gridDim.x; (void)ws; (void)bid; (void)G;
        EpiResidSplit e; e.PRE = (float*)(ws + W_PRE); e.r0 = nullptr; e.rb = (const bf16_t*)(ws + W_H1B); e.PS = (float*)(ws + W_PS); e.klen = 256;
        run_gemm_split(lds, (const bf16_t*)(ws + W_OX), (const bf16_t*)(ws + W_WXO), DM, XW, 256, e);
}
DEV void phase_fn10(const P* pp, LAS unsigned char* lds) {
    const P& p = *pp; unsigned char* ws = p.ws; const int bid = get_bid(), G = gridDim.x; (void)ws; (void)bid; (void)G;
        ln_phase((const float*)(ws + W_PRE), p.in[28], p.in[29], (bf16_t*)(ws + W_H2B), nullptr, nullptr, (const bf16_t*)(ws + W_H1B) + (size_t)MP * DM, (const float*)(ws + W_PS), 2);
}
DEV void phase_fn11(const P* pp, LAS unsigned char* lds) {
    const P& p = *pp; unsigned char* ws = p.ws; const int bid = get_bid(), G = gridDim.x; (void)ws; (void)bid; (void)G;
        EpiSwiglu e; e.F = (bf16_t*)(ws + W_F);
        run_gemm(lds, (const bf16_t*)(ws + W_H2B), (const bf16_t*)(ws + W_WFF13), MT, 2 * DFF, DM, e, bid);
}
DEV void phase_fn12(const P* pp, LAS unsigned char* lds) {
    const P& p = *pp; unsigned char* ws = p.ws; const int bid = get_bid(), G = gridDim.x; (void)ws; (void)bid; (void)G;
        EpiResidSplit e; e.PRE = (float*)(ws + W_PRE); e.r0 = nullptr; e.rb = (const bf16_t*)(ws + W_H2B); e.PS = (float*)(ws + W_PS); e.klen = 512;
        run_gemm_split(lds, (const bf16_t*)(ws + W_F), (const bf16_t*)(ws + W_WFF2), DM, DFF, 512, e);
}
DEV void phase_fn13(const P* pp, LAS unsigned char* lds) {
    const P& p = *pp; unsigned char* ws = p.ws; const int bid = get_bid(), G = gridDim.x; (void)ws; (void)bid; (void)G;
        ln_phase((const float*)(ws + W_PRE), p.in[33], p.in[34], nullptr, p.out + O_YP, nullptr, (const bf16_t*)(ws + W_H2B) + (size_t)MP * DM, (const float*)(ws + W_PS), 11);
}

__global__ void __launch_bounds__(512) mega(P p) {
    extern __shared__ __attribute__((aligned(16))) unsigned char lds_raw[];
    LAS unsigned char* lds = (LAS unsigned char*)lds_raw;
    cg::grid_group grid = cg::this_grid();
    const P* pp = &p;
    const int lo = p.ph_lo, hi = p.ph_hi, dupm = p.dup;
    if (threadIdx.x < 4) ((volatile LAS unsigned*)(lds + LDS_BYTES - 32))[threadIdx.x] = 0u;
    __syncthreads();
    const XcdBarrier xb = xcd_barrier_post((unsigned*)(p.ws + W_XBAR), (volatile LAS unsigned*)(lds + LDS_BYTES - 32));
    if (hi - lo > 1) grid.sync();
#ifndef DUP_MASK
#define DUP_MASK 0
#endif
#define RUN_PH(k) if (PH_ON(k) && lo <= k && k < hi) { const int nrep = 1 + ((dupm >> k) & 1); for (int r = 0; r < nrep; ++r) { if (r) xcd_barrier(xb); phase_fn##k(pp, lds); } } if (lo <= k && k + 1 < hi) xcd_barrier(xb);
    RUN_PH(0) RUN_PH(1) RUN_PH(2) RUN_PH(3) RUN_PH(4) RUN_PH(5) RUN_PH(6) RUN_PH(7) RUN_PH(8) RUN_PH(9) RUN_PH(10) RUN_PH(11) RUN_PH(12) RUN_PH(13)
}

extern "C" void kernel_launch(void* const* d_in, const int* in_sizes, int n_in, void* d_out, int out_size, void* d_ws, size_t ws_size, hipStream_t stream) {
    static int grid_blocks = 0;
    if (!grid_blocks) {
        if (n_in != 35 || ws_size < W_END) { fprintf(stderr, "kernel_launch: unexpected n_in %d or workspace %zu < %zu\n", n_in, ws_size, (size_t)W_END); grid_blocks = -1; return; }
        int dev = 0, cus = 0, per_cu = 0;
        hipGetDevice(&dev);
        hipDeviceGetAttribute(&cus, hipDeviceAttributeMultiprocessorCount, dev);
        if (hipFuncSetAttribute((const void*)mega, hipFuncAttributeMaxDynamicSharedMemorySize, LDS_BYTES) != hipSuccess) { fprintf(stderr, "kernel_launch: hipFuncSetAttribute failed\n"); grid_blocks = -1; return; }
        hipOccupancyMaxActiveBlocksPerMultiprocessor(&per_cu, (const void*)mega, 512, LDS_BYTES);
        if (per_cu < 1) { fprintf(stderr, "kernel_launch: occupancy query says %d blocks per CU\n", per_cu); per_cu = 1; }
        if (cus != 256) { fprintf(stderr, "kernel_launch: built for a 256-CU device (got %d)\n", cus); grid_blocks = -1; return; }
        grid_blocks = cus * 1;
        (void)hipGetLastError();
    }
    if (grid_blocks < 0) return;
    (void)hipMemsetAsync((unsigned char*)d_ws + W_MISC + 128, 0, 128 + 13824, stream);
    P p{};
    for (int i = 0; i < 35; ++i) p.in[i] = (const float*)d_in[i];
    p.out = (float*)d_out; p.ws = (unsigned char*)d_ws;
#if MK_PER_PHASE
#ifndef NPH_RUN
#define NPH_RUN NPHASE
#endif
    for (int ph = 0; ph < NPH_RUN; ++ph) { p.ph_lo = ph; p.ph_hi = ph + 1; hipLaunchKernelGGL(mega, dim3(grid_blocks), dim3(512), LDS_BYTES, stream, p); }
#else
    p.ph_lo = 0; p.ph_hi = NPHASE; p.dup = DUP_MASK;
    void* args[] = {&p};
    hipError_t e = hipLaunchCooperativeKernel((const void*)mega, dim3(grid_blocks), dim3(512), args, LDS_BYTES, stream);
    if (e != hipSuccess) fprintf(stderr, "cooperative launch failed: %s (grid %d)\n", hipGetErrorString(e), grid_blocks);
#endif
}
```
